# Optimizing an MI355X kernel written in HIP

```python
import math
import jax, jax.numpy as jnp
from jax import lax
import numpy as np

D_MODEL = 1024
BATCH = 8
SEQ = 2048
DEPTH = 1

D_MIX = D_MODEL
HEAD_DIM = 64
SB_HEADS = 8
SB_WIDTH = SB_HEADS * HEAD_DIM
SG_HEADS = 8
SG_WIDTH = SG_HEADS * HEAD_DIM
D_IN = 3 * SB_WIDTH + 2 * SG_WIDTH
CHUNK = 128
Q_BLOCK = 128
N_GROUPS = 4
EXPERTS_PER_GROUP = 8
TOP_K = 2
D_EXPERT = 512
EPS = 1e-6

kernel_name = "hymba_style_stickbreak_sgmlp_hiermoe"


def rmsnorm(x, g):
    xf = x.astype(jnp.float32)
    y = xf * lax.rsqrt(jnp.mean(xf * xf, axis=-1, keepdims=True) + EPS)
    return (y * g.astype(jnp.float32)).astype(x.dtype)


def stick_breaking_attention(q, k, v):
    B, S, H, Dh = q.shape
    nb = S // Q_BLOCK
    scale = 1.0 / math.sqrt(Dh)
    k = k.transpose(0, 2, 1, 3)
    v = v.transpose(0, 2, 1, 3)
    q_blocks = q.transpose(0, 2, 1, 3).reshape(B, H, nb, Q_BLOCK, Dh).transpose(2, 0, 1, 3, 4)
    key_pos = jnp.arange(S)

    def one_block(args):
        qb, blk = args
        z = jnp.einsum('bhqd,bhkd->bhqk', qb, k).astype(jnp.float32) * scale
        q_pos = blk * Q_BLOCK + jnp.arange(Q_BLOCK)
        mask = key_pos[None, :] < q_pos[:, None]
        log_beta = jax.nn.log_sigmoid(z)
        log_1m_beta = jnp.where(mask, jax.nn.log_sigmoid(-z), 0.0)
        after = lax.cumsum(log_1m_beta, axis=log_1m_beta.ndim - 1, reverse=True) - log_1m_beta
        a = jnp.where(mask, jnp.exp(log_beta + after), 0.0)
        return jnp.einsum('bhqk,bhkd->bhqd', a.astype(v.dtype), v)

    out = lax.map(one_block, (q_blocks, jnp.arange(nb)))
    return out.transpose(1, 0, 3, 2, 4).reshape(B, S, H * Dh)


def chunked_spatial_gating(u, vg, sg_norm_g, w_spatial, b_spatial):
    B, S, _ = u.shape
    nc = S // CHUNK
    u = jax.nn.gelu(u)
    vg = rmsnorm(jax.nn.gelu(vg), sg_norm_g)
    vg = vg.reshape(B, nc, CHUNK, SG_HEADS, HEAD_DIM)
    causal = jnp.tril(jnp.ones((CHUNK, CHUNK), dtype=w_spatial.dtype))
    w_masked = w_spatial * causal[None]
    mixed = jnp.einsum('hts,bcshd->bcthd', w_masked, vg) + b_spatial.T[None, None, :, :, None]
    return u * mixed.reshape(B, S, SG_WIDTH)


def hierarchical_moe(x, w_router_group, b_router_group, w_router_expert, b_router_expert,
                     w_gate, w_up, w_down):
    B, S, D = x.shape
    xt = x.reshape(-1, D)
    n = xt.shape[0]
    g_logits = (xt @ w_router_group).astype(jnp.float32) + b_router_group.astype(jnp.float32)
    g_probs = jax.nn.softmax(g_logits, axis=-1)
    g_idx = jnp.argmax(g_logits, axis=-1)
    g_onehot = jax.nn.one_hot(g_idx, N_GROUPS, dtype=jnp.float32)
    g_weight = jnp.sum(g_probs * g_onehot, axis=-1)
    e_logits_all = jnp.einsum('nd,gde->nge', xt, w_router_expert).astype(jnp.float32) \
        + b_router_expert.astype(jnp.float32)[None]
    e_logits = jnp.sum(e_logits_all * g_onehot[:, :, None], axis=1)
    e_probs = jax.nn.softmax(e_logits, axis=-1)
    top_p, top_i = lax.top_k(e_probs, TOP_K)
    top_p = top_p / jnp.sum(top_p, axis=-1, keepdims=True)
    e_w = jnp.sum(jax.nn.one_hot(top_i, EXPERTS_PER_GROUP, dtype=jnp.float32) * top_p[..., None], axis=1)
    combine = (g_onehot[:, :, None] * (g_weight[:, None] * e_w)[:, None, :]).astype(x.dtype)
    out = jnp.zeros((n, D), dtype=x.dtype)
    for g in range(N_GROUPS):
        h = jax.nn.silu(jnp.einsum('nd,edf->nef', xt, w_gate[g])) * jnp.einsum('nd,edf->nef', xt, w_up[g])
        out = out + jnp.einsum('nef,efd->nd', h * combine[:, g, :, None], w_down[g])
    return out.reshape(B, S, D)


def setup_inputs(seed: int = 0) -> dict:
    key = jax.random.key(seed)
    ks = jax.random.split(key, 20)
    f32 = jnp.float32
    nrm = lambda k, shape, s: jax.random.normal(k, shape, f32) * s
    gain = lambda k, shape: 1.0 + 0.02 * jax.random.normal(k, shape, f32)
    L, G, E = DEPTH, N_GROUPS, EXPERTS_PER_GROUP
    return {
        "x": jax.random.normal(ks[0], (BATCH, SEQ, D_MODEL), f32),
        "attn_norm_g": gain(ks[1], (L, D_MODEL)),
        "w_in": nrm(ks[2], (L, D_MODEL, D_IN), D_MODEL ** -0.5),
        "sg_norm_g": gain(ks[3], (L, SG_WIDTH)),
        "w_spatial": nrm(ks[4], (L, SG_HEADS, CHUNK, CHUNK), CHUNK ** -0.5),
        "b_spatial": gain(ks[5], (L, SG_HEADS, CHUNK)),
        "sb_out_norm_g": gain(ks[6], (L, SB_WIDTH)),
        "sg_out_norm_g": gain(ks[7], (L, SG_WIDTH)),
        "w_out": nrm(ks[8], (L, D_MIX, D_MODEL), D_MIX ** -0.5),
        "ffn_norm_g": gain(ks[9], (L, D_MODEL)),
        "w_router_group": nrm(ks[10], (L, D_MODEL, G), D_MODEL ** -0.5),
        "b_router_group": nrm(ks[11], (L, G), 0.01),
        "w_router_expert": nrm(ks[12], (L, G, D_MODEL, E), D_MODEL ** -0.5),
        "b_router_expert": nrm(ks[13], (L, G, E), 0.01),
        "w_gate": nrm(ks[14], (L, G, E, D_MODEL, D_EXPERT), D_MODEL ** -0.5),
        "w_up": nrm(ks[15], (L, G, E, D_MODEL, D_EXPERT), D_MODEL ** -0.5),
        "w_down": nrm(ks[16], (L, G, E, D_EXPERT, D_MODEL), D_EXPERT ** -0.5),
        "final_norm_g": gain(ks[17], (D_MODEL,)),
    }


def reference(x, attn_norm_g, w_in, sg_norm_g, w_spatial, b_spatial, sb_out_norm_g, sg_out_norm_g,
              w_out, ffn_norm_g, w_router_group, b_router_group, w_router_expert, b_router_expert,
              w_gate, w_up, w_down, final_norm_g):
    B, S, _ = x.shape
    h = x
    for layer in range(DEPTH):
        hn = rmsnorm(h, attn_norm_g[layer])
        proj = hn @ w_in[layer]
        q, k, v, u, vg = jnp.split(proj, [SB_WIDTH, 2 * SB_WIDTH, 3 * SB_WIDTH, 3 * SB_WIDTH + SG_WIDTH], axis=-1)
        shp = (B, S, SB_HEADS, HEAD_DIM)
        sb_out = stick_breaking_attention(q.reshape(shp), k.reshape(shp), v.reshape(shp))
        sg_out = chunked_spatial_gating(u, vg, sg_norm_g[layer], w_spatial[layer], b_spatial[layer])
        mixed = jnp.concatenate([rmsnorm(sb_out, sb_out_norm_g[layer]),
                                 rmsnorm(sg_out, sg_out_norm_g[layer])], axis=-1)
        h = h + mixed @ w_out[layer]
        hn = rmsnorm(h, ffn_norm_g[layer])
        h = h + hierarchical_moe(hn, w_router_group[layer], b_router_group[layer],
                                 w_router_expert[layer], b_router_expert[layer],
                                 w_gate[layer], w_up[layer], w_down[layer])
    return rmsnorm(h, final_norm_g)
```

```cpp
#include <hip/hip_runtime.h>
#include <cstdio>
#include <cstdint>
#include <cmath>
namespace naive {
constexpr int NTOK = 16384, DM = 1024, DIN = 2560, SEQ = 2048, NH = 8, HD = 64, CH = 128;
constexpr float EPS = 1e-6f;

__device__ __forceinline__ float wsum(float v) {
#pragma unroll
    for (int o = 1; o < 64; o <<= 1) v += __shfl_xor(v, o);
    return v;
}
__device__ __forceinline__ float gelu_tanh(float x) {
    const float y = 0.7978845608028654f * (x + 0.044715f * x * x * x);
    return 0.5f * x * (1.0f + tanhf(y));
}
__device__ __forceinline__ float log_sigmoid(float z) { return fminf(z, 0.f) - log1pf(expf(-fabsf(z))); }

__global__ void k_rmsnorm(const float* x, int ldx, const float* g, float* y, int ldy, int rows, int D) {
    const int row = blockIdx.x * 4 + (threadIdx.x >> 6), lane = threadIdx.x & 63;
    if (row >= rows) return;
    const float* xr = x + (size_t)row * ldx; float s = 0.f;
    for (int i = lane; i < D; i += 64) s += xr[i] * xr[i];
    s = wsum(s); const float r = rsqrtf(s / D + EPS);
    for (int i = lane; i < D; i += 64) y[(size_t)row * ldy + i] = xr[i] * r * g[i];
}
__global__ void k_gemm(const float* A, int lda, const float* B, int ldb, float* C, int ldc, int M, int N, int K, const float* R) {
    __shared__ float As[16][64 + 1], Bs[16][64 + 1];
    const int tx = threadIdx.x & 15, ty = threadIdx.x >> 4, m0 = blockIdx.y * 64, n0 = blockIdx.x * 64;
    float acc[4][4];
#pragma unroll
    for (int i = 0; i < 4; ++i)
#pragma unroll
        for (int j = 0; j < 4; ++j) acc[i][j] = 0.f;
    for (int k0 = 0; k0 < K; k0 += 16) {
        for (int i = threadIdx.x; i < 64 * 16; i += 256) { const int r = i >> 4, c = i & 15; As[c][r] = A[(size_t)(m0 + r) * lda + k0 + c]; }
        for (int i = threadIdx.x; i < 16 * 64; i += 256) { const int r = i >> 6, c = i & 63; Bs[r][c] = B[(size_t)(k0 + r) * ldb + n0 + c]; }
        __syncthreads();
#pragma unroll
        for (int kk = 0; kk < 16; ++kk) {
            float a[4], b[4];
#pragma unroll
            for (int i = 0; i < 4; ++i) { a[i] = As[kk][ty * 4 + i]; b[i] = Bs[kk][tx * 4 + i]; }
#pragma unroll
            for (int i = 0; i < 4; ++i)
#pragma unroll
                for (int j = 0; j < 4; ++j) acc[i][j] += a[i] * b[j];
        }
        __syncthreads();
    }
#pragma unroll
    for (int i = 0; i < 4; ++i)
#pragma unroll
        for (int j = 0; j < 4; ++j) { const size_t o = (size_t)(m0 + ty * 4 + i) * ldc + n0 + tx * 4 + j; C[o] = acc[i][j] + (R ? R[o] : 0.f); }
}
__global__ void k_attn(const float* qkv, float* sbo) {
    const int w = blockIdx.x * 4 + (threadIdx.x >> 6), lane = threadIdx.x & 63;
    const int t = w % SEQ, h = (w / SEQ) % NH, b = w / (SEQ * NH);
    const float* base = qkv + (size_t)b * SEQ * 1536;
    const float qd = base[(size_t)t * 1536 + h * 64 + lane];
    float o = 0.f, R = 0.f;
    for (int s = t - 1; s >= 0; --s) {
        const float z = wsum(qd * base[(size_t)s * 1536 + 512 + h * 64 + lane]) * 0.125f;
        const float lb = log_sigmoid(z);
        const float a = expf(lb + R);
        o += a * base[(size_t)s * 1536 + 1024 + h * 64 + lane];
        R += lb - z;
    }
    sbo[(size_t)(b * SEQ + t) * 512 + h * 64 + lane] = o;
}
__global__ void k_sg_prep(const float* uv, const float* g, float* vgn) {
    const int row = blockIdx.x * 4 + (threadIdx.x >> 6), lane = threadIdx.x & 63;
    float v[8], s = 0.f;
#pragma unroll
    for (int i = 0; i < 8; ++i) { v[i] = gelu_tanh(uv[(size_t)row * 1024 + 512 + lane + 64 * i]); s += v[i] * v[i]; }
    s = wsum(s); const float r = rsqrtf(s / 512.f + EPS);
#pragma unroll
    for (int i = 0; i < 8; ++i) vgn[(size_t)row * 512 + lane + 64 * i] = v[i] * r * g[lane + 64 * i];
}
__global__ void k_sg_mix(const float* uv, const float* vgn, const float* W, const float* bsp, float* sgo) {
    const int idx = blockIdx.x * 256 + threadIdx.x; const int row = idx / 512, c = idx % 512, h = c / 64;
    const int tl = row % CH, r0 = row - tl;
    float acc = 0.f;
    for (int s = 0; s <= tl; ++s) acc += W[(size_t)(h * CH + tl) * CH + s] * vgn[(size_t)(r0 + s) * 512 + c];
    acc += bsp[h * CH + tl];
    sgo[(size_t)row * 512 + c] = gelu_tanh(uv[(size_t)row * 1024 + c]) * acc;
}
__global__ void k_route(const float* hn2, const float* wrg, const float* brg, const float* wre, const float* bre, int* sel, float* cw) {
    const int tok = blockIdx.x * 4 + (threadIdx.x >> 6), lane = threadIdx.x & 63;
    const float* xr = hn2 + (size_t)tok * 1024;
    float gl[4];
#pragma unroll
    for (int g = 0; g < 4; ++g) { float s = 0.f; for (int k = lane; k < 1024; k += 64) s += xr[k] * wrg[k * 4 + g]; gl[g] = wsum(s) + brg[g]; }
    int gi = 0; float gm = gl[0];
#pragma unroll
    for (int g = 1; g < 4; ++g) if (gl[g] > gm) { gm = gl[g]; gi = g; }
    float den = 0.f;
#pragma unroll
    for (int g = 0; g < 4; ++g) den += expf(gl[g] - gm);
    const float gw = 1.f / den;
    float el[8];
#pragma unroll
    for (int e = 0; e < 8; ++e) { float s = 0.f; for (int k = lane; k < 1024; k += 64) s += xr[k] * wre[((size_t)gi * 1024 + k) * 8 + e]; el[e] = wsum(s) + bre[gi * 8 + e]; }
    int i1 = 0; float m1 = el[0];
#pragma unroll
    for (int e = 1; e < 8; ++e) if (el[e] > m1) { m1 = el[e]; i1 = e; }
    int i2 = -1; float m2 = -INFINITY;
#pragma unroll
    for (int e = 0; e < 8; ++e) if (e != i1 && el[e] > m2) { m2 = el[e]; i2 = e; }
    const float p2 = expf(m2 - m1), w1 = 1.f / (1.f + p2), w2 = p2 / (1.f + p2);
    if (lane == 0) { sel[tok * 2] = gi * 8 + i1; sel[tok * 2 + 1] = gi * 8 + i2; cw[tok * 2] = gw * w1; cw[tok * 2 + 1] = gw * w2; }
}
__global__ void __launch_bounds__(512) k_moe_final(const float* h1, const float* hn2, const int* sel, const float* cw, const float* wg, const float* wu, const float* wd,
                                                   const float* gfin, float* out) {
    __shared__ float xs[1024], hs[512], red[8];
    const int tok = blockIdx.x, tid = threadIdx.x;
    xs[tid] = hn2[(size_t)tok * 1024 + tid]; xs[tid + 512] = hn2[(size_t)tok * 1024 + tid + 512];
    float o0 = 0.f, o1 = 0.f;
    for (int kk = 0; kk < 2; ++kk) {
        const int e = sel[tok * 2 + kk]; const float c = cw[tok * 2 + kk];
        __syncthreads();
        const float* g = wg + (size_t)e * 1024 * 512; const float* u = wu + (size_t)e * 1024 * 512;
        float ag = 0.f, au = 0.f;
        for (int k = 0; k < 1024; ++k) { ag += xs[k] * g[(size_t)k * 512 + tid]; au += xs[k] * u[(size_t)k * 512 + tid]; }
        hs[tid] = (ag / (1.f + expf(-ag))) * au * c;
        __syncthreads();
        const float* d = wd + (size_t)e * 512 * 1024;
        for (int f = 0; f < 512; ++f) { o0 += hs[f] * d[(size_t)f * 1024 + tid]; o1 += hs[f] * d[(size_t)f * 1024 + tid + 512]; }
    }
    const float y0 = h1[(size_t)tok * 1024 + tid] + o0, y1 = h1[(size_t)tok * 1024 + tid + 512] + o1;
    float s = wsum(y0 * y0 + y1 * y1);
    if ((tid & 63) == 0) red[tid >> 6] = s;
    __syncthreads();
    s = 0.f;
#pragma unroll
    for (int i = 0; i < 8; ++i) s += red[i];
    const float r = rsqrtf(s / 1024.f + EPS);
    out[(size_t)tok * 1024 + tid] = y0 * r * gfin[tid]; out[(size_t)tok * 1024 + tid + 512] = y1 * r * gfin[tid + 512];
}
}
extern "C" void kernel_launch(void* const* d_in, const int* in_sizes, int n_in, void* d_out, int out_size, void* d_ws, size_t ws_size, hipStream_t stream) {
    using namespace naive;
    const float* x = (const float*)d_in[0]; const float* attn_g = (const float*)d_in[1]; const float* w_in = (const float*)d_in[2]; const float* sg_g = (const float*)d_in[3];
    const float* w_sp = (const float*)d_in[4]; const float* b_sp = (const float*)d_in[5]; const float* sbo_g = (const float*)d_in[6]; const float* sgo_g = (const float*)d_in[7];
    const float* w_out = (const float*)d_in[8]; const float* ffn_g = (const float*)d_in[9]; const float* wrg = (const float*)d_in[10]; const float* brg = (const float*)d_in[11];
    const float* wre = (const float*)d_in[12]; const float* bre = (const float*)d_in[13]; const float* wg = (const float*)d_in[14]; const float* wu = (const float*)d_in[15];
    const float* wd = (const float*)d_in[16]; const float* fin_g = (const float*)d_in[17];
    float* out = (float*)d_out; float* ws = (float*)d_ws;
    const size_t U = (size_t)NTOK * 512;
    float* U0 = ws; float* U2 = ws + 2 * U; float* U4 = ws + 4 * U; float* U5 = ws + 5 * U; int* sel = (int*)(ws + 6 * U); float* cw = ws + 6 * U + 2 * NTOK;
    k_rmsnorm<<<NTOK / 4, 256, 0, stream>>>(x, 1024, attn_g, U0, 1024, NTOK, 1024);
    k_gemm<<<dim3(1536 / 64, NTOK / 64), 256, 0, stream>>>(U0, 1024, w_in, 2560, U2, 1536, NTOK, 1536, 1024, nullptr);
    k_attn<<<NTOK * NH / 4, 256, 0, stream>>>(U2, U5);
    k_gemm<<<dim3(1024 / 64, NTOK / 64), 256, 0, stream>>>(U0, 1024, w_in + 1536, 2560, U2, 1024, NTOK, 1024, 1024, nullptr);
    k_sg_prep<<<NTOK / 4, 256, 0, stream>>>(U2, sg_g, U4);
    k_sg_mix<<<NTOK * 512 / 256, 256, 0, stream>>>(U2, U4, w_sp, b_sp, U0);
    k_rmsnorm<<<NTOK / 4, 256, 0, stream>>>(U5, 512, sbo_g, U2, 1024, NTOK, 512);
    k_rmsnorm<<<NTOK / 4, 256, 0, stream>>>(U0, 512, sgo_g, U2 + 512, 1024, NTOK, 512);
    k_gemm<<<dim3(1024 / 64, NTOK / 64), 256, 0, stream>>>(U2, 1024, w_out, 1024, U0, 1024, NTOK, 1024, 1024, x);
    k_rmsnorm<<<NTOK / 4, 256, 0, stream>>>(U0, 1024, ffn_g, U2, 1024, NTOK, 1024);
    k_route<<<NTOK / 4, 256, 0, stream>>>(U2, wrg, brg, wre, bre, sel, cw);
    k_moe_final<<<NTOK, 512, 0, stream>>>(U0, U2, sel, cw, wg, wu, wd, fin_g, out);
}
```

```cpp
#define TEST_STAGE 5
#include <hip/hip_runtime.h>
#include <cstdio>
#include <cstdint>
#include <cmath>
namespace pg8 {
#define PG8_LAS __attribute__((address_space(3)))
typedef unsigned short bf16_t;
typedef short bf16x8 __attribute__((ext_vector_type(8)));
typedef float f32x4 __attribute__((ext_vector_type(4)));
typedef float f32x2 __attribute__((ext_vector_type(2)));
typedef unsigned u32x4 __attribute__((ext_vector_type(4)));
typedef unsigned u32x2 __attribute__((ext_vector_type(2)));
constexpr int BM = 256, BK = 64, HALF = 128, HTB = HALF * BK * 2  , STAGE_BYTES = 8 * HTB, NXCD = 8, WGM = 8;

__host__ __device__ __forceinline__ int lds_byte(int r, int c) { const int st = (r >> 4) * 2 + (c >> 5), rr = r & 15, cc = c & 31, ob = rr * 64 + cc * 2; return st * 1024 + (ob ^ (((ob >> 9) & 1) << 5)); }
__host__ __device__ __forceinline__ void stage_rc(int b, int& R, int& C) { const int st = b / 1024, sb = b % 1024, swz = sb ^ (((sb >> 9) & 1) << 5); R = (st >> 1) * 16 + swz / 64; C = (st & 1) * 32 + (swz % 64) / 2; }
__host__ __device__ __forceinline__ int perm32(int rho) { const int n = rho >> 4, i = rho & 15; return 8 * (i >> 2) + 4 * n + (i & 3); }

struct Unit { int arow, brow, pm, pn, e, nvalid, lbase; };

struct StaticOrder {
    int nM, nN, nwg, G, c;
    __host__ __device__ void init(int M, int N, int G_, int c_) { nM = M / BM; nN = N / BM; nwg = nM * nN; G = G_; c = c_; }
    __host__ __device__ bool next(int i, Unit& u) const {
        const long L = (long)i * G + c; if (L >= nwg) return false;
        int wgid = (int)L; { const int q = nwg / NXCD, r = nwg % NXCD, xcd = wgid % NXCD, off = wgid / NXCD; wgid = (xcd < r ? xcd * (q + 1) : r * (q + 1) + (xcd - r) * q) + off; }
        const int nig = WGM * nN, gid = wgid / nig, fm = gid * WGM, gsz = (nM - fm) < WGM ? (nM - fm) : WGM;
        u.pm = fm + ((wgid % nig) % gsz); u.pn = (wgid % nig) / gsz; u.arow = u.pm * BM; u.brow = u.pn * BM; u.e = 0; u.nvalid = BM; u.lbase = 0; return true;
    }
    PG8_LAS unsigned char* gtab;
};

__device__ __forceinline__ unsigned cvt_pk_bf16(float lo, float hi) { unsigned r; asm volatile("v_cvt_pk_bf16_f32 %0, %1, %2" : "=v"(r) : "v"(lo), "v"(hi)); return r; }

template <class Epi, class Sched, bool ALIGN_EPI, bool GATHER>
__device__ __forceinline__ void gemm_phase(PG8_LAS unsigned char* lds, const bf16_t* Aglob, const bf16_t* Btglob, const int K, const Sched& S, const Epi& E) {
    int tid_ = threadIdx.x; asm volatile("" : "+v"(tid_));
    const int tid = tid_, wid = __builtin_amdgcn_readfirstlane(tid >> 6), lane = tid & 63, wr = wid >> 2, wc = wid & 3, fr = lane & 15, fq = lane >> 4;
    const int nt = K / BK;
    int RA[2], CA[2]; unsigned voffB[2];
#pragma unroll
    for (int i = 0; i < 2; ++i) { int R, C; stage_rc(tid * 16 + i * 8192, R, C); const int Rb = Epi::PERM ? ((R & ~31) + perm32(R & 31)) : R;
        RA[i] = R; CA[i] = C; voffB[i] = (unsigned)(Rb * K + C) * 2u; }
    const size_t kstep = (size_t)(BK * 2);
    const size_t hstep = (size_t)HALF * K * 2;
    const unsigned ldsw = (unsigned)wid * 1024u;
    const int aoff = lds_byte(wr * 64 + fr, fq * 8), boff = lds_byte(wc * 32 + fr, fq * 8);
#define PG8_SA(b, h) (((b) * 2 + (h)) * HTB)
#define PG8_SB(b, h) ((4 + (b) * 2 + (h)) * HTB)
#define PG8_STAGE(bufoff, gbase, voff) do { _Pragma("unroll") for (int _i = 0; _i < 2; ++_i) \
        __builtin_amdgcn_global_load_lds((const unsigned*)((const char*)(gbase) + (voff)[_i]), (PG8_LAS unsigned*)(lds + (bufoff) + ldsw + _i * 8192), 16, 0, 0); } while (0)
#define PG8_LDA(dst, b, h) do { _Pragma("unroll") for (int m = 0; m < 4; ++m) _Pragma("unroll") for (int k = 0; k < 2; ++k) dst[m][k] = *(const PG8_LAS bf16x8*)(lds + PG8_SA(b, h) + aoff + m * 2048 + k * 1024); } while (0)
#define PG8_LDB(dst, b, h) do { _Pragma("unroll") for (int n = 0; n < 2; ++n) _Pragma("unroll") for (int k = 0; k < 2; ++k) dst[n][k] = *(const PG8_LAS bf16x8*)(lds + PG8_SB(b, h) + boff + n * 2048 + k * 1024); } while (0)
#define PG8_MMA(ai, bj, At, Bt) do { __builtin_amdgcn_s_setprio(1); _Pragma("unroll") for (int m = 0; m < 4; ++m) _Pragma("unroll") for (int n = 0; n < 2; ++n) _Pragma("unroll") for (int k = 0; k < 2; ++k) \
        acc[ai][bj][m][n] = __builtin_amdgcn_mfma_f32_16x16x32_bf16(Bt[n][k], At[m][k], acc[ai][bj][m][n], 0, 0, 0); __builtin_amdgcn_s_setprio(0); } while (0)
#define PG8_WAIT_V(n) asm volatile("s_waitcnt vmcnt(" #n ")" ::: "memory")
#define PG8_WAIT_L(n) asm volatile("s_waitcnt lgkmcnt(" #n ")" ::: "memory")
#define PG8_BAR __builtin_amdgcn_s_barrier()
#define PG8_SCHED __builtin_amdgcn_sched_barrier(0)
#define PG8_AOFFS(V, UI) do { if constexpr (GATHER) { const u32x4 _t = *(const PG8_LAS u32x4*)(S.gtab + ((UI) * 512 + tid) * 16); V[0][0] = _t.x; V[0][1] = _t.y; V[1][0] = _t.z; V[1][1] = _t.w; } \
        else { _Pragma("unroll") for (int _h = 0; _h < 2; ++_h) _Pragma("unroll") for (int _i = 0; _i < 2; ++_i) V[_h][_i] = (unsigned)((_h * HALF + RA[_i]) * K + CA[_i]) * 2u; } } while (0)
#define PG8_ABASE(U) (GATHER ? (const char*)Aglob : (const char*)Aglob + (size_t)(U).arow * K * 2)
    Unit cur, nxt; int ui = 0;
    if (!S.next(0, cur)) return;
    f32x4 acc[2][2][4][2];
#pragma unroll
    for (int a = 0; a < 2; ++a)
#pragma unroll
        for (int b = 0; b < 2; ++b)
#pragma unroll
            for (int m = 0; m < 4; ++m)
#pragma unroll
                for (int n = 0; n < 2; ++n) acc[a][b][m][n] = (f32x4){0.f, 0.f, 0.f, 0.f};
    bf16x8 At[4][2], B0[2][2], B1[2][2];
    unsigned vc[2][2];
    PG8_AOFFS(vc, 0);
    const char* cA = PG8_ABASE(cur); const char* cB = (const char*)Btglob + (size_t)cur.brow * K * 2;
    PG8_STAGE(PG8_SB(0, 0), cB, voffB); PG8_STAGE(PG8_SB(0, 1), cB + hstep, voffB); PG8_STAGE(PG8_SA(0, 0), cA, vc[0]); PG8_STAGE(PG8_SA(0, 1), cA, vc[1]);
    if (wr == 1) PG8_BAR;
    PG8_WAIT_V(2); PG8_BAR;
    PG8_STAGE(PG8_SB(1, 0), cB + kstep, voffB); PG8_STAGE(PG8_SA(1, 0), cA + kstep, vc[0]); PG8_STAGE(PG8_SB(1, 1), cB + hstep + kstep, voffB);
    PG8_WAIT_V(6); PG8_BAR;
    for (;;) {
        const bool has_next = S.next(ui + 1, nxt);
        const char* nA = has_next ? PG8_ABASE(nxt) : cA; const char* nB = has_next ? (const char*)Btglob + (size_t)nxt.brow * K * 2 : cB;
        for (int t = 0; t < nt; t += 2) {
            const bool last = (t == nt - 2);
            const char* a1 = cA + (size_t)(t + 1) * kstep;
            const char* a2 = last ? nA : cA + (size_t)(t + 2) * kstep; const char* b2 = last ? nB : cB + (size_t)(t + 2) * kstep;
            const char* a3 = a2 + kstep; const char* b3 = b2 + kstep;
            PG8_LDB(B0, 0, 0); PG8_LDB(B1, 0, 1); PG8_SCHED; PG8_LDA(At, 0, 0); PG8_STAGE(PG8_SA(1, 1), a1, vc[1]);
            if constexpr (GATHER) { if (last && has_next) PG8_AOFFS(vc, ui + 1); }
            PG8_WAIT_V(8); PG8_WAIT_L(0); PG8_BAR; PG8_MMA(0, 0, At, B0); PG8_MMA(0, 1, At, B1); PG8_BAR; PG8_SCHED;
            PG8_LDA(At, 0, 1); PG8_STAGE(PG8_SB(0, 0), b2, voffB); PG8_STAGE(PG8_SB(0, 1), b2 + hstep, voffB); PG8_STAGE(PG8_SA(0, 0), a2, vc[0]);
            PG8_WAIT_V(8); PG8_WAIT_L(0); PG8_BAR; PG8_MMA(1, 0, At, B0); PG8_MMA(1, 1, At, B1); PG8_BAR; PG8_SCHED;
            PG8_LDB(B0, 1, 0); PG8_LDB(B1, 1, 1); PG8_SCHED; PG8_LDA(At, 1, 0); PG8_STAGE(PG8_SA(0, 1), a2, vc[1]);
            PG8_WAIT_V(8); PG8_WAIT_L(0); PG8_BAR; PG8_MMA(0, 0, At, B0); PG8_MMA(0, 1, At, B1); PG8_BAR; PG8_SCHED;
            PG8_LDA(At, 1, 1); PG8_STAGE(PG8_SB(1, 0), b3, voffB); PG8_STAGE(PG8_SB(1, 1), b3 + hstep, voffB); PG8_STAGE(PG8_SA(1, 0), a3, vc[0]);
            PG8_WAIT_V(8); PG8_WAIT_L(0); PG8_BAR; PG8_MMA(1, 0, At, B0); PG8_MMA(1, 1, At, B1); PG8_BAR; PG8_SCHED;
        }
        if constexpr (ALIGN_EPI) { if (wr == 0) PG8_BAR; }
        E(acc, cur, wr, wc, fr, fq);
        if (!has_next) break;
#pragma unroll
        for (int a = 0; a < 2; ++a)
#pragma unroll
            for (int b = 0; b < 2; ++b)
#pragma unroll
                for (int m = 0; m < 4; ++m)
#pragma unroll
                    for (int n = 0; n < 2; ++n) acc[a][b][m][n] = (f32x4){0.f, 0.f, 0.f, 0.f};
        cur = nxt; cA = nA; cB = nB; ++ui;
        if constexpr (ALIGN_EPI) { if (wr == 1) PG8_BAR; }
    }
    PG8_WAIT_V(0);
    if constexpr (!ALIGN_EPI) { if (wr == 0) PG8_BAR; }
    PG8_BAR;
#undef PG8_SA
#undef PG8_SB
#undef PG8_STAGE
#undef PG8_LDA
#undef PG8_LDB
#undef PG8_MMA
#undef PG8_WAIT_V
#undef PG8_WAIT_L
#undef PG8_BAR
#undef PG8_SCHED
#undef PG8_AOFFS
#undef PG8_ABASE
}
}
constexpr int NTOK = 16384, DM = 1024, DIN = 2560, SEQ = 2048, NB = 8, NH = 8, HD = 64, CH = 128, NCH = 16, NE = 32, DE = 512, CAP = 16384;
constexpr float EPS = 1e-6f;
constexpr float C2 = 0.125f * 1.4426950408889634f;
constexpr int NWAVES = 8;
constexpr size_t MiB = 1u << 20;
constexpr size_t WS_CTL = 0, CTL_ZERO_BYTES = 64 * 1024;
constexpr size_t WS_SSQV = 1 * MiB, WS_SSQH = 1 * MiB + 64 * 1024, WS_TOKSLOT = 1 * MiB + 128 * 1024;
constexpr size_t WS_LIST = 2 * MiB, WS_COMB = 4 * MiB;
constexpr size_t WS_WR = 6 * MiB, WS_WSP = 6 * MiB + 512 * 1024;
constexpr size_t WS_WIN = 7 * MiB, WS_WOUT = 12 * MiB, WS_WGU = 14 * MiB, WS_WD = 78 * MiB;
constexpr size_t WS_H1B = 110 * MiB;
constexpr size_t WS_GUF = 142 * MiB, WS_GVF = 158 * MiB;
constexpr size_t WS_H = 142 * MiB;
constexpr size_t WS_HN = 174 * MiB, WS_QF = 206 * MiB, WS_KF = 222 * MiB, WS_VF = 238 * MiB;
constexpr size_t WS_MIXED = WS_HN, WS_Y = WS_HN, WS_END = 254 * MiB;
constexpr int CW_BAR = 4096;
constexpr int CW_CNT = 8192;
static_assert((CW_CNT + 64 * NE) * 4 <= (int)CTL_ZERO_BYTES, "ctl");
constexpr int RING_OFF = 0, RING_BYTES = 131072;
constexpr int MISC_OFF = RING_BYTES;
constexpr int GTAB_OFF = MISC_OFF + 4096;
constexpr int LDS_BYTES = 163840;

#define GAS __attribute__((address_space(1)))
#define LAS __attribute__((address_space(3)))
typedef unsigned short bf16;
typedef unsigned v4u __attribute__((ext_vector_type(4)));
typedef unsigned v2u __attribute__((ext_vector_type(2)));
typedef float f32x4 __attribute__((ext_vector_type(4)));
typedef float f32x16 __attribute__((ext_vector_type(16)));
typedef short bf16x8 __attribute__((ext_vector_type(8)));
typedef GAS unsigned gu32;
#define RLX_AGENT __ATOMIC_RELAXED, __HIP_MEMORY_SCOPE_AGENT
#define LDS_WAIT() asm volatile("s_waitcnt lgkmcnt(0)" ::: "memory")
#define VM_WAIT() asm volatile("s_waitcnt vmcnt(0)" ::: "memory")
__device__ __forceinline__ unsigned f2bf(float f) { unsigned u = __builtin_bit_cast(unsigned, f); return (u + 0x7fffu + ((u >> 16) & 1u)) >> 16; }
__device__ __forceinline__ unsigned pk2(float lo, float hi) { return f2bf(lo) | (f2bf(hi) << 16); }
__device__ __forceinline__ float bf2f(unsigned short b) { return __builtin_bit_cast(float, (unsigned)b << 16); }
__device__ __forceinline__ float bflo(unsigned w) { return __builtin_bit_cast(float, w << 16); }
__device__ __forceinline__ float bfhi(unsigned w) { return __builtin_bit_cast(float, w & 0xffff0000u); }
__device__ __forceinline__ int crow(int r, int hi) { return (r & 3) + 8 * (r >> 2) + 4 * hi; }
__device__ __forceinline__ int perm16(int i) { return (i & 3) + 4 * ((i >> 3) & 1) + 8 * ((i >> 2) & 1); }
__device__ __forceinline__ float gelu_tanh_f(float x) {
    const float y = x * (0.7978845608028654f + 0.0356774081363001f * x * x);
    return x * __builtin_amdgcn_rcpf(1.0f + __builtin_amdgcn_exp2f(-2.885390081777927f * y));
}
__device__ __forceinline__ float wave_sum(float v) {
#pragma unroll
    for (int o = 1; o < 64; o <<= 1) v += __shfl_xor(v, o);
    return v;
}

__host__ __device__ __forceinline__ size_t qk_index(int bh, int s, int d) { return ((((size_t)bh * 64 + (s >> 5)) * 4 + (d >> 4)) * 64 + ((d >> 3) & 1) * 32 + (s & 31)) * 8 + (d & 7); }
__host__ __device__ __forceinline__ size_t v_index(int bh, int s, int d) { const int i = s & 15, pos = (i & 3) + 4 * ((i >> 3) & 1) + 8 * ((i >> 2) & 1);
    return ((((((size_t)bh * 32 + (s >> 6)) * 2 + (d >> 5)) * 4 + ((s >> 4) & 3)) * 64 + (pos >> 3) * 32 + (d & 31)) * 8 + (pos & 7)); }
__host__ __device__ __forceinline__ size_t gu_index(int b, int s, int h, int d) { const int c = s >> 7, tb = (s >> 5) & 3, t = s & 31, db = d >> 5, dl = d & 31, hh = (dl >> 2) & 1, r = (dl & 3) + 4 * (dl >> 3);
    return (((((((size_t)b * 16 + c) * 8 + h) * 4 + tb) * 2 + db) * 64 + hh * 32 + t) * 16 + r); }
__host__ __device__ __forceinline__ size_t gv_index(int b, int s, int h, int d) { const int c = s >> 7, ks = (s & 127) >> 4;
    return (((((((size_t)b * 16 + c) * 8 + h) * 2 + (d >> 5)) * 8 + ks) * 64 + ((s >> 3) & 1) * 32 + (d & 31)) * 8 + (s & 7)); }

#define XB_TMO      128
#define XB_XCNT(j)  (256  + 64 * (j))
#define XB_XSUB(j)  (1280 + 64 * (j))
#define XB_XGEN(j)  (2304 + 64 * (j))
#define XB_TOP      3328
#define XB_TOPGEN   3392
#define XCD_BAR_WORDS 3456
#define XB_SPIN_CAP (1u << 18)
__device__ __forceinline__ unsigned xb_ld(unsigned* p)              { return __hip_atomic_load(p, __ATOMIC_RELAXED, __HIP_MEMORY_SCOPE_AGENT); }
__device__ __forceinline__ unsigned xb_add(unsigned* p, unsigned v) { return __hip_atomic_fetch_add(p, v, __ATOMIC_RELAXED, __HIP_MEMORY_SCOPE_AGENT); }
__device__ __forceinline__ unsigned xb_xcc_id() { return (unsigned)__builtin_amdgcn_s_getreg((3 << 11) | 20) & 0xFu; }
#define XB_SPIN(cond, bar) do { unsigned _sp = 0; while (cond) { __builtin_amdgcn_s_sleep(1); \
    if ((++_sp & 255u) == 0u) { if (xb_ld(&(bar)[XB_TMO])) break; if (_sp > XB_SPIN_CAP) { atomicAdd(&(bar)[XB_TMO], 1u); break; } } } } while (0)
struct XcdBarrier { unsigned* bar; unsigned x; volatile LAS unsigned* st; };
__device__ __forceinline__ XcdBarrier xcd_barrier_post(unsigned* bar, volatile LAS unsigned* st) {
    XcdBarrier b; b.bar = bar; b.x = xb_xcc_id(); b.st = st;
    if (threadIdx.x == 0) (void)xb_add(&bar[XB_XCNT(b.x)], 1u);
    return b;
}
__device__ __forceinline__ void xcd_barrier_complete(unsigned* bar, unsigned x, unsigned& nloc, unsigned& nx) {
    const unsigned G = gridDim.x * gridDim.y * gridDim.z;
    unsigned sum, cnt, mine, sp = 0u;
    for (;;) {
        sum = 0u; cnt = 0u; mine = 0u;
#pragma unroll
        for (unsigned j = 0; j < 16; ++j) { const unsigned c = xb_ld(&bar[XB_XCNT(j)]); sum += c; cnt += (c > 0u) ? 1u : 0u; mine = (j == x) ? c : mine; }
        if (sum == G) break;
        __builtin_amdgcn_s_sleep(1);
        if ((++sp & 255u) == 0u) { if (xb_ld(&bar[XB_TMO])) break; if (sp > XB_SPIN_CAP) { atomicAdd(&bar[XB_TMO], 1u); break; } }
    }
    nloc = mine > 0u ? mine : 1u; nx = cnt > 0u ? cnt : 1u;
}
__device__ __forceinline__ void xcd_barrier(const XcdBarrier& b) {
    asm volatile("s_waitcnt vmcnt(0)" ::: "memory");
    __syncthreads();
    if (threadIdx.x == 0) {
        unsigned* bar = b.bar;
        __builtin_amdgcn_s_waitcnt(0);
        unsigned nloc = b.st[0], nx = b.st[1];
        if (nloc == 0u) { xcd_barrier_complete(bar, b.x, nloc, nx); b.st[0] = nloc; b.st[1] = nx; }
        const unsigned old = xb_add(&bar[XB_XSUB(b.x)], 1u);
        const unsigned gen = old / nloc;
        if (old + 1u == (gen + 1u) * nloc) {
            __builtin_amdgcn_fence(__ATOMIC_RELEASE, "agent");
            asm volatile("s_waitcnt vmcnt(0)" ::: "memory");
            const unsigned og = xb_add(&bar[XB_TOP], 1u);
            const unsigned tg = og / nx;
            if (og + 1u == (tg + 1u) * nx) xb_add(&bar[XB_TOPGEN], 1u);
            else XB_SPIN(xb_ld(&bar[XB_TOPGEN]) == tg, bar);
            __builtin_amdgcn_fence(__ATOMIC_ACQUIRE, "agent");
            xb_add(&bar[XB_XGEN(b.x)], 1u);
            asm volatile("s_waitcnt vmcnt(0)" ::: "memory");
        } else {
            XB_SPIN(xb_ld(&bar[XB_XGEN(b.x)]) == gen, bar);
            __builtin_amdgcn_fence(__ATOMIC_ACQUIRE, "agent");
            asm volatile("s_waitcnt vmcnt(0)" ::: "memory");
        }
    }
    __syncthreads();
}

struct Frame {
    LAS unsigned char* lds;
    volatile LAS unsigned* MISC;
    gu32* ctl;
    int tid, lane, wave, vcu, G;
    const float *x, *attn_g, *w_in, *sg_g, *w_sp, *b_sp, *sbo_g, *sgo_g, *w_out, *ffn_g, *wrg, *brg, *wre, *bre, *wg, *wu, *wd, *fin_g;
    float* out;
    unsigned char* ws;
};
__device__ __forceinline__ void p0_transpose_item(const float* W, int K, int N, bf16* WT, int row_off, const float* gk, LAS float* scr, int item, int lane) {
    const int nblk = N / 32, kb = item / nblk, nb = item % nblk, k0 = 64 * kb, n0 = 32 * nb;
#pragma unroll 8
    for (int i = 0; i < 32; ++i) { const int kk = 2 * i + (lane >> 5); const float g = gk ? gk[k0 + kk] : 1.0f; scr[kk * 33 + (lane & 31)] = W[(size_t)(k0 + kk) * N + n0 + (lane & 31)] * g; }
    LDS_WAIT(); asm volatile("" ::: "memory");
    const int c = lane & 7;
#pragma unroll
    for (int j = 0; j < 4; ++j) { const int n = (lane >> 3) + 8 * j; const LAS float* s = scr + (8 * c) * 33 + n;
        v4u o; o.x = pk2(s[0 * 33], s[1 * 33]); o.y = pk2(s[2 * 33], s[3 * 33]); o.z = pk2(s[4 * 33], s[5 * 33]); o.w = pk2(s[6 * 33], s[7 * 33]);
        *(GAS v4u*)(WT + (size_t)(row_off + n0 + n) * K + k0 + 8 * c) = o; }
    LDS_WAIT(); asm volatile("" ::: "memory");
}
__device__ __forceinline__ void rms_row_to_bf16(int lane, const float* xrow, bf16* orow) {
    const GAS f32x4* xr = (const GAS f32x4*)xrow + lane;
    f32x4 v[4]; float s = 0.f;
#pragma unroll
    for (int j = 0; j < 4; ++j) { v[j] = xr[64 * j]; s += (v[j].x * v[j].x + v[j].y * v[j].y) + (v[j].z * v[j].z + v[j].w * v[j].w); }
    const float rstd = rsqrtf(wave_sum(s) * (1.f / DM) + EPS);
    GAS unsigned long long* o8 = (GAS unsigned long long*)orow + lane;
#pragma unroll
    for (int j = 0; j < 4; ++j) o8[64 * j] = (unsigned long long)pk2(v[j].x * rstd, v[j].y * rstd) | ((unsigned long long)pk2(v[j].z * rstd, v[j].w * rstd) << 32);
}
__device__ __forceinline__ void p0_prologue(Frame& F) {
    LAS float* scr = (LAS float*)(F.lds + RING_OFF + F.wave * 16384);
    const int gw = F.vcu * NWAVES + F.wave, NGW = F.G * NWAVES;
    const int gt = gw * 64 + F.lane, NGT = NGW * 64;
    bf16* WIN = (bf16*)(F.ws + WS_WIN); bf16* WOUT = (bf16*)(F.ws + WS_WOUT); bf16* WGU = (bf16*)(F.ws + WS_WGU); bf16* WD = (bf16*)(F.ws + WS_WD);
    { float* sv = (float*)(F.ws + WS_SSQV); float* sh = (float*)(F.ws + WS_SSQH);
      for (int i = gt; i < NTOK; i += NGT) { sv[i] = 0.f; sh[i] = 0.f; } }
    { bf16* WRH = (bf16*)(F.ws + WS_WR); bf16* WRL = WRH + 64 * 1024;
      for (int i = gt; i < 64 * 1024; i += NGT) { const int n = i >> 10, k = i & 1023; float w = 0.f;
          if (n < 4) w = F.wrg[k * 4 + n]; else if (n < 36) { const int g = (n - 4) >> 3, e = (n - 4) & 7; w = F.wre[((size_t)g * 1024 + k) * 8 + e]; }
          w *= F.ffn_g[k]; const unsigned hb = f2bf(w); const float hf = bf2f((unsigned short)hb); WRH[i] = (bf16)hb; WRL[i] = (bf16)f2bf(w - hf); } }
    { bf16* WSP = (bf16*)(F.ws + WS_WSP);
      for (int i = gt; i < NH * CH * CH; i += NGT) { const int s = i & 127, t = (i >> 7) & 127; WSP[i] = (s <= t) ? (bf16)f2bf(F.w_sp[i]) : (bf16)0; } }
    { bf16* HN = (bf16*)(F.ws + WS_HN);
      for (int m = gw; m < NTOK; m += NGW) rms_row_to_bf16(F.lane, F.x + (size_t)m * DM, HN + (size_t)m * DM); }
    constexpr int I_IN = (DM / 64) * (DIN / 32), I_OUT = (DM / 64) * (DM / 32), I_G = (DM / 64) * (DE / 32), I_D = (DE / 64) * (DM / 32);
    constexpr int NITEMS = I_IN + I_OUT + NE * (2 * I_G + I_D);
    for (int it = gw; it < NITEMS; it += NGW) {
        int r = it;
        if (r < I_IN) { p0_transpose_item(F.w_in, DM, DIN, WIN, 0, F.attn_g, scr, r, F.lane); continue; } r -= I_IN;
        if (r < I_OUT) { const int kb = r / (DM / 32); const float* g = (kb < 8) ? F.sbo_g : (F.sgo_g - 512); p0_transpose_item(F.w_out, DM, DM, WOUT, 0, g, scr, r, F.lane); continue; } r -= I_OUT;
        const int e = r / (2 * I_G + I_D); r -= e * (2 * I_G + I_D);
        if (r < 2 * I_G) { const int up = r / I_G; r -= up * I_G; const int nb = r % (DE / 32), n0 = 32 * nb, pn = n0 >> 7, j0 = n0 & 127;
            const float* W = (up ? F.wu : F.wg) + (size_t)e * DM * DE;
            p0_transpose_item(W, DM, DE, WGU, (4 * e + pn) * 256 + 128 * up + j0 - n0, F.ffn_g, scr, r, F.lane); continue; }
        r -= 2 * I_G;
        p0_transpose_item(F.wd + (size_t)e * DE * DM, DE, DM, WD, e * DM, nullptr, scr, r, F.lane);
    }
}
using pg8::Unit; using pg8::cvt_pk_bf16;
struct EpiInProj {
    static constexpr bool PERM = true;
    bf16 *QF, *KF, *VF, *GUF, *GVF; float* ssqv;
    __device__ __forceinline__ void operator()(const f32x4 (&acc)[2][2][4][2], const Unit& u, int wr, int wc, int fr, int fq) const {
        const int seg = u.pn >> 1, b = u.pm >> 3, sbase = (u.pm & 7) * 256 + wr * 64;
        const int db = wc & 1;
        if (seg <= 1) {
            bf16* dst = seg == 0 ? QF : KF; const float sc = seg == 0 ? C2 : 1.0f;
            const int dstep = 2 * db + (fq >> 1), hh = fq & 1;
#pragma unroll
            for (int bj = 0; bj < 2; ++bj) { const int bh = b * 8 + (u.pn & 1) * 4 + 2 * bj + (wc >> 1);
#pragma unroll
                for (int ai = 0; ai < 2; ++ai)
#pragma unroll
                    for (int m = 0; m < 4; ++m) { const int s = sbase + 128 * ai + 16 * m + fr;
                        const f32x4 v0 = acc[ai][bj][m][0] * sc, v1 = acc[ai][bj][m][1] * sc;
                        v4u w; w.x = cvt_pk_bf16(v0[0], v0[1]); w.y = cvt_pk_bf16(v0[2], v0[3]); w.z = cvt_pk_bf16(v1[0], v1[1]); w.w = cvt_pk_bf16(v1[2], v1[3]);
                        *(v4u*)(dst + ((((size_t)bh * 64 + (s >> 5)) * 4 + dstep) * 64 + hh * 32 + (s & 31)) * 8) = w; } }
        } else if (seg == 2) {
            const int pos = perm16(fr), hh = pos >> 3, pj = pos & 7;
#pragma unroll
            for (int bj = 0; bj < 2; ++bj) { const int bh = b * 8 + (u.pn & 1) * 4 + 2 * bj + (wc >> 1);
#pragma unroll
                for (int ai = 0; ai < 2; ++ai)
#pragma unroll
                    for (int m = 0; m < 4; ++m) { const int s = sbase + 128 * ai + 16 * m;
                        bf16* base = VF + ((((size_t)bh * 32 + (s >> 6)) * 2 + db) * 4 + ((s >> 4) & 3)) * 512 + (hh * 32 + 8 * fq) * 8 + pj;
#pragma unroll
                        for (int n = 0; n < 2; ++n)
#pragma unroll
                            for (int i = 0; i < 4; ++i) base[(4 * n + i) * 8] = (bf16)f2bf(acc[ai][bj][m][n][i]); } }
        } else if (seg == 3) {
#pragma unroll
            for (int bj = 0; bj < 2; ++bj) { const int h = (u.pn & 1) * 4 + 2 * bj + (wc >> 1);
#pragma unroll
                for (int ai = 0; ai < 2; ++ai)
#pragma unroll
                    for (int m = 0; m < 4; ++m) { const int s = sbase + 128 * ai + 16 * m + fr, c = s >> 7, tb = (s >> 5) & 3, t = s & 31;
                        bf16* base = GUF + ((((((size_t)b * 16 + c) * 8 + h) * 4 + tb) * 2 + db) * 64 + t) * 16 + 4 * fq;
#pragma unroll
                        for (int n = 0; n < 2; ++n) { const f32x4 v = acc[ai][bj][m][n];
                            v2u w; w.x = cvt_pk_bf16(gelu_tanh_f(v[0]), gelu_tanh_f(v[1])); w.y = cvt_pk_bf16(gelu_tanh_f(v[2]), gelu_tanh_f(v[3]));
                            *(v2u*)(base + n * 32 * 16) = w; } } }
        } else {
            const int hh = fr >> 3, pj = fr & 7;
#pragma unroll
            for (int ai = 0; ai < 2; ++ai)
#pragma unroll
                for (int m = 0; m < 4; ++m) { const int s = sbase + 128 * ai + 16 * m, c = s >> 7, ks = (s & 127) >> 4; float ss = 0.f;
#pragma unroll
                    for (int bj = 0; bj < 2; ++bj) { const int h = (u.pn & 1) * 4 + 2 * bj + (wc >> 1);
                        bf16* base = GVF + ((((((size_t)b * 16 + c) * 8 + h) * 2 + db) * 8 + ks) * 64 + hh * 32 + 8 * fq) * 8 + pj;
#pragma unroll
                        for (int n = 0; n < 2; ++n)
#pragma unroll
                            for (int i = 0; i < 4; ++i) { const float g = gelu_tanh_f(acc[ai][bj][m][n][i]); ss += g * g; base[(4 * n + i) * 8] = (bf16)f2bf(g); } }
                    ss += __shfl_xor(ss, 16); ss += __shfl_xor(ss, 32);
                    if (fq == 0) atomicAdd(ssqv + (size_t)b * SEQ + s + fr, ss); }
        }
    }
};
struct EpiOutProj {
    static constexpr bool PERM = true;
    const float* x; bf16* H1B; float* ssqh;
    __device__ __forceinline__ void operator()(const f32x4 (&acc)[2][2][4][2], const Unit& u, int wr, int wc, int fr, int fq) const {
#pragma unroll
        for (int ai = 0; ai < 2; ++ai)
#pragma unroll
            for (int m = 0; m < 4; ++m) { const int row = u.pm * 256 + 128 * ai + 64 * wr + 16 * m + fr; float ss = 0.f;
#pragma unroll
                for (int bj = 0; bj < 2; ++bj) { const size_t o = (size_t)row * DM + u.pn * 256 + 128 * bj + 32 * wc + 8 * fq;
                    const f32x4 v0 = acc[ai][bj][m][0] + *(const f32x4*)(x + o), v1 = acc[ai][bj][m][1] + *(const f32x4*)(x + o + 4);
                    ss += (v0[0] * v0[0] + v0[1] * v0[1]) + (v0[2] * v0[2] + v0[3] * v0[3]) + (v1[0] * v1[0] + v1[1] * v1[1]) + (v1[2] * v1[2] + v1[3] * v1[3]);
                    v4u w; w.x = cvt_pk_bf16(v0[0], v0[1]); w.y = cvt_pk_bf16(v0[2], v0[3]); w.z = cvt_pk_bf16(v1[0], v1[1]); w.w = cvt_pk_bf16(v1[2], v1[3]);
                    *(v4u*)(H1B + o) = w; }
                ss += __shfl_xor(ss, 16); ss += __shfl_xor(ss, 32);
                if (fq == 0) atomicAdd(ssqh + row, ss); }
    }
};
struct GroupedOrder {
    volatile LAS unsigned* tp; volatile LAS unsigned* rp; volatile LAS unsigned* cn; const int* list; int G, c; LAS unsigned char* gtab;
    __device__ __forceinline__ bool next(int i, Unit& u) const {
        const unsigned L = (unsigned)i * G + c, nunits = tp[32] * 4u; if (L >= nunits) return false;
        const unsigned tile = L >> 2; int e = 0;
        for (int j = 1; j < 32; ++j) e += (tp[j] <= tile) ? 1 : 0;
        const int rt = tile - tp[e];
        u.e = e; u.pn = L & 3; u.brow = 256 * (4 * e + u.pn); u.pm = rp[e] + 256 * rt; u.arow = u.pm;
        const int left = (int)cn[e] - 256 * rt; u.nvalid = left < 256 ? left : 256; u.lbase = e * CAP + 256 * rt; return true;
    }
    __device__ __forceinline__ int grow(const Unit& u, int j) const { const int jj = j < u.nvalid ? j : u.nvalid - 1; return list[u.lbase + jj]; }
    __device__ __forceinline__ void fill_gtab(int tid, int K) const {
        int RA[2], CA[2];
#pragma unroll
        for (int i = 0; i < 2; ++i) pg8::stage_rc(tid * 16 + i * 8192, RA[i], CA[i]);
        Unit u;
        for (int ui = 0; ui < 3 && next(ui, u); ++ui) { v4u t;
            t.x = (unsigned)((size_t)grow(u, RA[0]) * K + CA[0]) * 2u; t.y = (unsigned)((size_t)grow(u, RA[1]) * K + CA[1]) * 2u;
            t.z = (unsigned)((size_t)grow(u, 128 + RA[0]) * K + CA[0]) * 2u; t.w = (unsigned)((size_t)grow(u, 128 + RA[1]) * K + CA[1]) * 2u;
            *(LAS v4u*)(gtab + (ui * 512 + tid) * 16) = t; }
        __syncthreads();
    }
};
struct EpiGateUp {
    static constexpr bool PERM = true;
    const int* list; const float* comb; const float* ssqh; bf16* H;
    __device__ __forceinline__ void operator()(const f32x4 (&acc)[2][2][4][2], const Unit& u, int wr, int wc, int fr, int fq) const {
#pragma unroll
        for (int ai = 0; ai < 2; ++ai)
#pragma unroll
            for (int m = 0; m < 4; ++m) { const int r = 128 * ai + 64 * wr + 16 * m + fr;
                if (r < u.nvalid) { const int tok = list[u.lbase + r]; const float cw = comb[u.lbase + r]; const float rs = rsqrtf(ssqh[tok] * (1.f / DM) + EPS);
                    float hv[8];
#pragma unroll
                    for (int n = 0; n < 2; ++n)
#pragma unroll
                        for (int i = 0; i < 4; ++i) { const float g = acc[ai][0][m][n][i] * rs, up = acc[ai][1][m][n][i] * rs;
                            hv[4 * n + i] = g * __builtin_amdgcn_rcpf(1.0f + __builtin_amdgcn_exp2f(-1.4426950408889634f * g)) * up * cw; }
                    v4u w; w.x = cvt_pk_bf16(hv[0], hv[1]); w.y = cvt_pk_bf16(hv[2], hv[3]); w.z = cvt_pk_bf16(hv[4], hv[5]); w.w = cvt_pk_bf16(hv[6], hv[7]);
                    *(v4u*)(H + (size_t)(u.pm + r) * DE + 128 * u.pn + 32 * wc + 8 * fq) = w; } }
    }
};
struct EpiDown {
    static constexpr bool PERM = true;
    bf16* Y;
    __device__ __forceinline__ void operator()(const f32x4 (&acc)[2][2][4][2], const Unit& u, int wr, int wc, int fr, int fq) const {
#pragma unroll
        for (int ai = 0; ai < 2; ++ai)
#pragma unroll
            for (int m = 0; m < 4; ++m) { const int r = 128 * ai + 64 * wr + 16 * m + fr;
                if (r < u.nvalid) {
#pragma unroll
                    for (int bj = 0; bj < 2; ++bj) { const f32x4 v0 = acc[ai][bj][m][0], v1 = acc[ai][bj][m][1];
                        v4u w; w.x = cvt_pk_bf16(v0[0], v0[1]); w.y = cvt_pk_bf16(v0[2], v0[3]); w.z = cvt_pk_bf16(v1[0], v1[1]); w.w = cvt_pk_bf16(v1[2], v1[3]);
                        *(v4u*)(Y + (size_t)(u.pm + r) * DM + 256 * u.pn + 128 * bj + 32 * wc + 8 * fq) = w; } } }
    }
};
template <bool DIAG>
__device__ __forceinline__ void sb_block(const bf16x8 (&kf)[4], const bf16x8 (&vf)[4], const bf16x8 (&qf)[4], f32x16& o0, f32x16& o1, float& Pc, int q, int hh) {
    f32x16 st = {};
#pragma unroll
    for (int ds = 0; ds < 4; ++ds) st = __builtin_amdgcn_mfma_f32_32x32x16_bf16(kf[ds], qf[ds], st, 0, 0, 0);
    float bt[16], om[16];
#pragma unroll
    for (int r = 0; r < 16; ++r) {
        const float z = __builtin_fmaxf(st[r], -100.0f);
        const float e = __builtin_amdgcn_exp2f(-z);
        float b = __builtin_amdgcn_rcpf(1.0f + e), o = e * b;
        if (DIAG) { const bool valid = crow(r, hh) < q; b = valid ? b : 0.0f; o = valid ? o : 1.0f; }
        bt[r] = b; om[r] = o;
    }
    float gp[4], pg[4], pr[4];
#pragma unroll
    for (int g = 0; g < 4; ++g) { gp[g] = (om[4 * g] * om[4 * g + 1]) * (om[4 * g + 2] * om[4 * g + 3]); pg[g] = __shfl_xor(gp[g], 32); pr[g] = gp[g] * pg[g]; }
    const float T3 = Pc, T2 = T3 * pr[3], T1 = T2 * pr[2], T0 = T1 * pr[1];
    const float Tn[4] = {T0, T1, T2, T3};
    float a[16];
#pragma unroll
    for (int g = 0; g < 4; ++g) {
        float t = Tn[g] * (hh ? 1.0f : pg[g]);
        a[4 * g + 3] = bt[4 * g + 3] * t; t *= om[4 * g + 3];
        a[4 * g + 2] = bt[4 * g + 2] * t; t *= om[4 * g + 2];
        a[4 * g + 1] = bt[4 * g + 1] * t; t *= om[4 * g + 1];
        a[4 * g] = bt[4 * g] * t;
    }
    Pc = T0 * pr[0];
    v4u p0, p1;
    p0.x = cvt_pk_bf16(a[0], a[1]); p0.y = cvt_pk_bf16(a[2], a[3]); p0.z = cvt_pk_bf16(a[4], a[5]); p0.w = cvt_pk_bf16(a[6], a[7]);
    p1.x = cvt_pk_bf16(a[8], a[9]); p1.y = cvt_pk_bf16(a[10], a[11]); p1.z = cvt_pk_bf16(a[12], a[13]); p1.w = cvt_pk_bf16(a[14], a[15]);
    const bf16x8 pa0 = __builtin_bit_cast(bf16x8, p0), pa1 = __builtin_bit_cast(bf16x8, p1);
    o0 = __builtin_amdgcn_mfma_f32_32x32x16_bf16(vf[0], pa0, o0, 0, 0, 0); o0 = __builtin_amdgcn_mfma_f32_32x32x16_bf16(vf[1], pa1, o0, 0, 0, 0);
    o1 = __builtin_amdgcn_mfma_f32_32x32x16_bf16(vf[2], pa0, o1, 0, 0, 0); o1 = __builtin_amdgcn_mfma_f32_32x32x16_bf16(vf[3], pa1, o1, 0, 0, 0);
}
#define SB_LOAD(KD, VD, kb_) do { const int _kb = (kb_); \
    _Pragma("unroll") for (int _d = 0; _d < 4; ++_d) KD[_d] = KFv[(((size_t)bh * 64 + _kb) * 4 + _d) * 64 + lane]; \
    _Pragma("unroll") for (int _d = 0; _d < 2; ++_d) _Pragma("unroll") for (int _s = 0; _s < 2; ++_s) VD[_d * 2 + _s] = VFv[((((size_t)bh * 32 + (_kb >> 1)) * 2 + _d) * 4 + 2 * (_kb & 1) + _s) * 64 + lane]; } while (0)

__device__ __forceinline__ void attn_task(Frame& F, int b, int qb, LAS float* red) {
    const int lane = F.lane, h = F.wave, bh = b * 8 + h, q = lane & 31, hh = lane >> 5;
    const GAS bf16x8* QFv = (const GAS bf16x8*)(F.ws + WS_QF); const GAS bf16x8* KFv = (const GAS bf16x8*)(F.ws + WS_KF); const GAS bf16x8* VFv = (const GAS bf16x8*)(F.ws + WS_VF);
    bf16x8 qf[4], kf[4], vf[4], kn[4], vn[4];
#pragma unroll
    for (int ds = 0; ds < 4; ++ds) qf[ds] = QFv[(((size_t)bh * 64 + qb) * 4 + ds) * 64 + lane];
    SB_LOAD(kf, vf, qb);
    f32x16 o0 = {}, o1 = {}; float Pc = 1.0f;
    { const int kp = qb > 0 ? qb - 1 : 0; SB_LOAD(kn, vn, kp); }
    sb_block<true>(kf, vf, qf, o0, o1, Pc, q, hh);
    for (int kb = qb - 1; kb >= 0; --kb) {
        if (__all(Pc < 1.1754944e-38f)) break;
#pragma unroll
        for (int i = 0; i < 4; ++i) { kf[i] = kn[i]; vf[i] = vn[i]; }
        { const int kp = kb > 0 ? kb - 1 : 0; SB_LOAD(kn, vn, kp); }
        sb_block<false>(kf, vf, qf, o0, o1, Pc, q, hh);
    }
    float ss = 0.f;
#pragma unroll
    for (int r = 0; r < 16; ++r) ss += o0[r] * o0[r] + o1[r] * o1[r];
    ss += __shfl_xor(ss, 32);
    if (hh == 0) red[h * 32 + q] = ss;
    __syncthreads();
    float tot = 0.f;
#pragma unroll
    for (int w = 0; w < 8; ++w) tot += red[w * 32 + q];
    const float rstd = rsqrtf(tot * (1.f / 512.f) + EPS);
    bf16* mrow = (bf16*)(F.ws + WS_MIXED) + ((size_t)b * SEQ + qb * 32 + q) * DM + h * 64 + 4 * hh;
#pragma unroll
    for (int g = 0; g < 4; ++g) {
        v2u w0, w1;
        w0.x = cvt_pk_bf16(o0[4 * g] * rstd, o0[4 * g + 1] * rstd); w0.y = cvt_pk_bf16(o0[4 * g + 2] * rstd, o0[4 * g + 3] * rstd);
        w1.x = cvt_pk_bf16(o1[4 * g] * rstd, o1[4 * g + 1] * rstd); w1.y = cvt_pk_bf16(o1[4 * g + 2] * rstd, o1[4 * g + 3] * rstd);
        *(GAS v2u*)(mrow + 8 * g) = w0; *(GAS v2u*)(mrow + 32 + 8 * g) = w1;
    }
    __syncthreads();
}

__device__ __forceinline__ void sg_task(Frame& F, int b, int c, int p, LAS float* rsv, LAS float* red) {
    const int lane = F.lane, h = F.wave, t = lane & 31, hh = lane >> 5;
    const float* ssqv = (const float*)(F.ws + WS_SSQV);
    if (F.tid < 128) rsv[F.tid] = rsqrtf(__hip_atomic_load(ssqv + (size_t)b * SEQ + c * 128 + F.tid, RLX_AGENT) * (1.f / 512.f) + EPS);
    __syncthreads();
    const int tbA = p ? 2 : 3, tbB = p ? 1 : 0, KS = 2 * (tbA + 1), KSB = 2 * (tbB + 1);
    const GAS bf16x8* GVv = (const GAS bf16x8*)(F.ws + WS_GVF) + (((size_t)b * 16 + c) * 8 + h) * 2 * 8 * 64;
    const GAS bf16x8* WSv = (const GAS bf16x8*)(F.ws + WS_WSP);
    const float g0 = F.sg_g[h * 64 + t], g1 = F.sg_g[h * 64 + 32 + t];
    f32x16 aA0 = {}, aA1 = {}, aB0 = {}, aB1 = {};
    for (int ks = 0; ks < KS; ++ks) {
        const bf16x8 r0 = GVv[(0 * 8 + ks) * 64 + lane], r1 = GVv[(1 * 8 + ks) * 64 + lane];
        const bf16x8 wA = WSv[((size_t)(h * 128 + 32 * tbA + t) * 128 + 16 * ks + 8 * hh) >> 3];
        const f32x4 s0 = *(const LAS f32x4*)(rsv + 16 * ks + 8 * hh), s1 = *(const LAS f32x4*)(rsv + 16 * ks + 8 * hh + 4);
        const v4u u0 = __builtin_bit_cast(v4u, r0), u1 = __builtin_bit_cast(v4u, r1);
        v4u x0, x1;
        x0.x = cvt_pk_bf16(bflo(u0.x) * s0[0] * g0, bfhi(u0.x) * s0[1] * g0); x0.y = cvt_pk_bf16(bflo(u0.y) * s0[2] * g0, bfhi(u0.y) * s0[3] * g0);
        x0.z = cvt_pk_bf16(bflo(u0.z) * s1[0] * g0, bfhi(u0.z) * s1[1] * g0); x0.w = cvt_pk_bf16(bflo(u0.w) * s1[2] * g0, bfhi(u0.w) * s1[3] * g0);
        x1.x = cvt_pk_bf16(bflo(u1.x) * s0[0] * g1, bfhi(u1.x) * s0[1] * g1); x1.y = cvt_pk_bf16(bflo(u1.y) * s0[2] * g1, bfhi(u1.y) * s0[3] * g1);
        x1.z = cvt_pk_bf16(bflo(u1.z) * s1[0] * g1, bfhi(u1.z) * s1[1] * g1); x1.w = cvt_pk_bf16(bflo(u1.w) * s1[2] * g1, bfhi(u1.w) * s1[3] * g1);
        const bf16x8 a0 = __builtin_bit_cast(bf16x8, x0), a1 = __builtin_bit_cast(bf16x8, x1);
        aA0 = __builtin_amdgcn_mfma_f32_32x32x16_bf16(a0, wA, aA0, 0, 0, 0); aA1 = __builtin_amdgcn_mfma_f32_32x32x16_bf16(a1, wA, aA1, 0, 0, 0);
        if (ks < KSB) { const bf16x8 wB = WSv[((size_t)(h * 128 + 32 * tbB + t) * 128 + 16 * ks + 8 * hh) >> 3];
            aB0 = __builtin_amdgcn_mfma_f32_32x32x16_bf16(a0, wB, aB0, 0, 0, 0); aB1 = __builtin_amdgcn_mfma_f32_32x32x16_bf16(a1, wB, aB1, 0, 0, 0); }
    }
    const GAS bf16x8* GUv = (const GAS bf16x8*)(F.ws + WS_GUF) + ((((size_t)b * 16 + c) * 8 + h) * 4) * 2 * 64 * 2;
    const float biasA = F.b_sp[h * 128 + 32 * tbA + t], biasB = F.b_sp[h * 128 + 32 * tbB + t];
    float ssA = 0.f, ssB = 0.f;
#define SG_GATE(ACC, TB, DB, BIAS, SS) do { const bf16x8 _g0 = GUv[(((TB) * 2 + (DB)) * 64 + lane) * 2], _g1 = GUv[(((TB) * 2 + (DB)) * 64 + lane) * 2 + 1]; \
        _Pragma("unroll") for (int _r = 0; _r < 8; ++_r) { ACC[_r] = bf2f((unsigned short)_g0[_r]) * (ACC[_r] + BIAS); ACC[_r + 8] = bf2f((unsigned short)_g1[_r]) * (ACC[_r + 8] + BIAS); \
            SS += ACC[_r] * ACC[_r] + ACC[_r + 8] * ACC[_r + 8]; } } while (0)
    SG_GATE(aA0, tbA, 0, biasA, ssA); SG_GATE(aA1, tbA, 1, biasA, ssA); SG_GATE(aB0, tbB, 0, biasB, ssB); SG_GATE(aB1, tbB, 1, biasB, ssB);
#undef SG_GATE
    ssA += __shfl_xor(ssA, 32); ssB += __shfl_xor(ssB, 32);
    if (hh == 0) { red[h * 32 + t] = ssA; red[256 + h * 32 + t] = ssB; }
    __syncthreads();
    float totA = 0.f, totB = 0.f;
#pragma unroll
    for (int w = 0; w < 8; ++w) { totA += red[w * 32 + t]; totB += red[256 + w * 32 + t]; }
    const float rsA = rsqrtf(totA * (1.f / 512.f) + EPS), rsB = rsqrtf(totB * (1.f / 512.f) + EPS);
    bf16* mA = (bf16*)(F.ws + WS_MIXED) + ((size_t)b * SEQ + c * 128 + 32 * tbA + t) * DM + 512 + h * 64 + 4 * hh;
    bf16* mB = (bf16*)(F.ws + WS_MIXED) + ((size_t)b * SEQ + c * 128 + 32 * tbB + t) * DM + 512 + h * 64 + 4 * hh;
#pragma unroll
    for (int g = 0; g < 4; ++g) {
        v2u w;
        w.x = cvt_pk_bf16(aA0[4 * g] * rsA, aA0[4 * g + 1] * rsA); w.y = cvt_pk_bf16(aA0[4 * g + 2] * rsA, aA0[4 * g + 3] * rsA); *(GAS v2u*)(mA + 8 * g) = w;
        w.x = cvt_pk_bf16(aA1[4 * g] * rsA, aA1[4 * g + 1] * rsA); w.y = cvt_pk_bf16(aA1[4 * g + 2] * rsA, aA1[4 * g + 3] * rsA); *(GAS v2u*)(mA + 32 + 8 * g) = w;
        w.x = cvt_pk_bf16(aB0[4 * g] * rsB, aB0[4 * g + 1] * rsB); w.y = cvt_pk_bf16(aB0[4 * g + 2] * rsB, aB0[4 * g + 3] * rsB); *(GAS v2u*)(mB + 8 * g) = w;
        w.x = cvt_pk_bf16(aB1[4 * g] * rsB, aB1[4 * g + 1] * rsB); w.y = cvt_pk_bf16(aB1[4 * g + 2] * rsB, aB1[4 * g + 3] * rsB); *(GAS v2u*)(mB + 32 + 8 * g) = w;
    }
    __syncthreads();
}

__device__ __forceinline__ void p2_phase(Frame& F) {
    LAS float* red = (LAS float*)(F.lds + RING_OFF); LAS float* rsv = red + 512;
    for (int i = F.vcu; i < 256; i += F.G) sg_task(F, i >> 5, (i >> 1) & 15, i & 1, rsv, red);
    for (int i = F.vcu; i < 512; i += F.G) { const int j = 511 - i; attn_task(F, j >> 6, j & 63, red); }
}
__device__ __forceinline__ void route_task(Frame& F, int task) {
    const int lane = F.lane, w = F.wave, tg = w & 1, kq = w >> 1, r32 = lane & 31, hh = lane >> 5;
    LAS float* part = (LAS float*)(F.lds + RING_OFF);
    LAS unsigned* lc = (LAS unsigned*)(F.lds + RING_OFF + 4 * 64 * 65 * 4);
    const int tok0 = task * 64;
    const GAS bf16x8* Av = (const GAS bf16x8*)(F.ws + WS_H1B);
    const GAS bf16x8* Wh = (const GAS bf16x8*)(F.ws + WS_WR); const GAS bf16x8* Wl = Wh + 64 * 128;
    if (F.tid < 64) lc[F.tid] = 0u;
    f32x16 c0 = {}, c1 = {};
#pragma unroll 4
    for (int ks = 0; ks < 16; ++ks) {
        const int kv = kq * 32 + ks * 2 + hh;
        const bf16x8 a = Av[(size_t)(tok0 + tg * 32 + r32) * 128 + kv];
        const bf16x8 b0h = Wh[(size_t)r32 * 128 + kv], b0l = Wl[(size_t)r32 * 128 + kv], b1h = Wh[(size_t)(32 + r32) * 128 + kv], b1l = Wl[(size_t)(32 + r32) * 128 + kv];
        c0 = __builtin_amdgcn_mfma_f32_32x32x16_bf16(a, b0h, c0, 0, 0, 0); c0 = __builtin_amdgcn_mfma_f32_32x32x16_bf16(a, b0l, c0, 0, 0, 0);
        c1 = __builtin_amdgcn_mfma_f32_32x32x16_bf16(a, b1h, c1, 0, 0, 0); c1 = __builtin_amdgcn_mfma_f32_32x32x16_bf16(a, b1l, c1, 0, 0, 0);
    }
#pragma unroll
    for (int r = 0; r < 16; ++r) { const int tk = tg * 32 + crow(r, hh); part[(kq * 64 + tk) * 65 + r32] = c0[r]; part[(kq * 64 + tk) * 65 + 32 + r32] = c1[r]; }
    __syncthreads();
    int e1 = 0, e2 = 0, rk1 = 0, rk2 = 0; float cw1 = 0.f, cw2 = 0.f;
    const int tok = tok0 + F.tid;
    if (F.tid < 64) {
        const float rs = rsqrtf(__hip_atomic_load((float*)(F.ws + WS_SSQH) + tok, RLX_AGENT) * (1.f / DM) + EPS);
#define LG(n) ((part[(0 * 64 + F.tid) * 65 + (n)] + part[(1 * 64 + F.tid) * 65 + (n)]) + (part[(2 * 64 + F.tid) * 65 + (n)] + part[(3 * 64 + F.tid) * 65 + (n)]))
        float gl[4];
#pragma unroll
        for (int g = 0; g < 4; ++g) gl[g] = LG(g) * rs + F.brg[g];
        int gi = 0; float gm = gl[0];
#pragma unroll
        for (int g = 1; g < 4; ++g) if (gl[g] > gm) { gm = gl[g]; gi = g; }
        float den = 0.f;
#pragma unroll
        for (int g = 0; g < 4; ++g) den += __expf(gl[g] - gm);
        const float gw = 1.f / den;
        int i1 = 0, i2 = 0; float m1 = -INFINITY, m2 = -INFINITY;
        for (int e = 0; e < 8; ++e) { const float v = LG(4 + gi * 8 + e) * rs + F.bre[gi * 8 + e];
            if (v > m1) { m2 = m1; i2 = i1; m1 = v; i1 = e; } else if (v > m2) { m2 = v; i2 = e; } }
#undef LG
        const float p2 = __expf(m2 - m1), w1 = 1.f / (1.f + p2);
        e1 = gi * 8 + i1; e2 = gi * 8 + i2; cw1 = gw * w1; cw2 = gw * (p2 * w1);
        rk1 = (int)atomicAdd((unsigned*)&lc[e1], 1u); rk2 = (int)atomicAdd((unsigned*)&lc[e2], 1u);
    }
    __syncthreads();
    if (F.tid < 32) { const unsigned n = lc[F.tid]; lc[32 + F.tid] = n ? __hip_atomic_fetch_add((unsigned*)(F.ctl + CW_CNT + 64 * F.tid), n, RLX_AGENT) : 0u; }
    __syncthreads();
    if (F.tid < 64) {
        int* list = (int*)(F.ws + WS_LIST); float* comb = (float*)(F.ws + WS_COMB); unsigned* slot = (unsigned*)(F.ws + WS_TOKSLOT);
        const int p1 = (int)lc[32 + e1] + rk1, p2_ = (int)lc[32 + e2] + rk2;
        list[e1 * CAP + p1] = tok; comb[e1 * CAP + p1] = cw1; slot[tok * 2] = ((unsigned)e1 << 16) | (unsigned)p1;
        list[e2 * CAP + p2_] = tok; comb[e2 * CAP + p2_] = cw2; slot[tok * 2 + 1] = ((unsigned)e2 << 16) | (unsigned)p2_;
    }
    __syncthreads();
}
__device__ __forceinline__ void load_prefix(Frame& F) {
    if (F.tid == 0) { unsigned tp = 0, rp = 0;
        for (int e = 0; e < 32; ++e) { const unsigned n = __hip_atomic_load((unsigned*)(F.ctl + CW_CNT + 64 * e), RLX_AGENT);
            F.MISC[16 + e] = tp; F.MISC[64 + e] = rp; F.MISC[128 + e] = n; tp += (n + 255u) >> 8; rp += n; }
        F.MISC[16 + 32] = tp; F.MISC[64 + 32] = rp; }
    __syncthreads();
}
__device__ __forceinline__ void p6_final(Frame& F) {
    const int gw = F.vcu * NWAVES + F.wave, NGW = F.G * NWAVES, lane = F.lane;
    const bf16* H1B = (const bf16*)(F.ws + WS_H1B); const bf16* Y = (const bf16*)(F.ws + WS_Y); const unsigned* slot = (const unsigned*)(F.ws + WS_TOKSLOT);
    for (int tok = gw; tok < NTOK; tok += NGW) {
        const unsigned s1 = slot[tok * 2], s2 = slot[tok * 2 + 1];
        const size_t r1 = F.MISC[64 + (s1 >> 16)] + (s1 & 0xffffu), r2 = F.MISC[64 + (s2 >> 16)] + (s2 & 0xffffu);
        float v[16]; float ss = 0.f;
#pragma unroll
        for (int j = 0; j < 2; ++j) { const int col = j * 512 + lane * 8;
            const v4u a = *(const GAS v4u*)(H1B + (size_t)tok * DM + col), y1 = *(const GAS v4u*)(Y + r1 * DM + col), y2 = *(const GAS v4u*)(Y + r2 * DM + col);
#pragma unroll
            for (int i = 0; i < 4; ++i) { v[8 * j + 2 * i] = bflo(a[i]) + bflo(y1[i]) + bflo(y2[i]); v[8 * j + 2 * i + 1] = bfhi(a[i]) + bfhi(y1[i]) + bfhi(y2[i]); } }
#pragma unroll
        for (int i = 0; i < 16; ++i) ss += v[i] * v[i];
        const float rstd = rsqrtf(wave_sum(ss) * (1.f / DM) + EPS);
#pragma unroll
        for (int j = 0; j < 2; ++j) { const int col = j * 512 + lane * 8; const f32x4 g0 = *(const f32x4*)(F.fin_g + col), g1 = *(const f32x4*)(F.fin_g + col + 4);
            f32x4 o0, o1;
#pragma unroll
            for (int i = 0; i < 4; ++i) { o0[i] = v[8 * j + i] * rstd * g0[i]; o1[i] = v[8 * j + 4 + i] * rstd * g1[i]; }
            *(GAS f32x4*)(F.out + (size_t)tok * DM + col) = o0; *(GAS f32x4*)(F.out + (size_t)tok * DM + col + 4) = o1; }
    }
}
struct Args { const float* in[18]; float* out; unsigned char* ws; int ph_lo, ph_hi; };
constexpr int N_PHASES = 7;
__global__ void __launch_bounds__(NWAVES * 64, 2) mk_fwd(Args args) {
    extern __shared__ __attribute__((aligned(16))) unsigned char lds[];
    Frame F;
    F.lds = (LAS unsigned char*)lds;
    F.MISC = (volatile LAS unsigned*)(F.lds + MISC_OFF);
#define REFRESH() do { int t_ = threadIdx.x; asm volatile("" : "+v"(t_)); F.tid = t_; F.lane = t_ & 63; F.wave = __builtin_amdgcn_readfirstlane(t_ >> 6); } while (0)
    REFRESH();
    F.G = gridDim.x; { const int bx = blockIdx.x; F.vcu = (F.G % 8 == 0) ? (bx % 8) * (F.G / 8) + bx / 8 : bx; }
    F.ws = args.ws; F.ctl = (gu32*)(args.ws + WS_CTL); F.out = args.out;
    F.x = args.in[0]; F.attn_g = args.in[1]; F.w_in = args.in[2]; F.sg_g = args.in[3]; F.w_sp = args.in[4]; F.b_sp = args.in[5]; F.sbo_g = args.in[6]; F.sgo_g = args.in[7];
    F.w_out = args.in[8]; F.ffn_g = args.in[9]; F.wrg = args.in[10]; F.brg = args.in[11]; F.wre = args.in[12]; F.bre = args.in[13]; F.wg = args.in[14]; F.wu = args.in[15];
    F.wd = args.in[16]; F.fin_g = args.in[17];
    for (int u = F.tid; u < 4096 / 4; u += NWAVES * 64) ((LAS unsigned*)(F.lds + MISC_OFF))[u] = 0u;
    __syncthreads();
    const int lo = args.ph_lo, hi = args.ph_hi;
    XcdBarrier bar; bar.bar = (unsigned*)(F.ctl + CW_BAR); bar.x = 0; bar.st = nullptr;
    if (hi - lo > 1) bar = xcd_barrier_post((unsigned*)(F.ctl + CW_BAR), F.MISC + 0);
#ifndef PH_MASK
#define PH_MASK 0xff
#endif
#define IN(k) (((PH_MASK >> (k)) & 1) && lo <= (k) && (k) < hi)
#define SEAM(k) do { if (IN(k) && IN((k) + 1)) xcd_barrier(bar); } while (0)
    if (IN(0)) { REFRESH(); p0_prologue(F); SEAM(0); }
    if (IN(1)) {
        pg8::StaticOrder S; S.init(NTOK, DIN, F.G, (int)blockIdx.x);
        EpiInProj E{(bf16*)(F.ws + WS_QF), (bf16*)(F.ws + WS_KF), (bf16*)(F.ws + WS_VF), (bf16*)(F.ws + WS_GUF), (bf16*)(F.ws + WS_GVF), (float*)(F.ws + WS_SSQV)};
        pg8::gemm_phase<EpiInProj, pg8::StaticOrder, true, false>(F.lds + RING_OFF, (const bf16*)(F.ws + WS_HN), (const bf16*)(F.ws + WS_WIN), DM, S, E);
        SEAM(1);
    }
    if (IN(2)) { REFRESH(); p2_phase(F); SEAM(2); }
    if (IN(3)) {
        pg8::StaticOrder S; S.init(NTOK, DM, F.G, (int)blockIdx.x);
        EpiOutProj E{F.x, (bf16*)(F.ws + WS_H1B), (float*)(F.ws + WS_SSQH)};
        pg8::gemm_phase<EpiOutProj, pg8::StaticOrder, false, false>(F.lds + RING_OFF, (const bf16*)(F.ws + WS_MIXED), (const bf16*)(F.ws + WS_WOUT), DM, S, E);
        SEAM(3);
    }
    if (IN(4)) { REFRESH(); for (int t = F.vcu; t < NTOK / 64; t += F.G) route_task(F, t); SEAM(4); }
    if (IN(5)) {
        REFRESH(); load_prefix(F);
        GroupedOrder S{F.MISC + 16, F.MISC + 64, F.MISC + 128, (const int*)(F.ws + WS_LIST), F.G, F.vcu, F.lds + GTAB_OFF};
        S.fill_gtab(F.tid, DM);
        EpiGateUp E{(const int*)(F.ws + WS_LIST), (const float*)(F.ws + WS_COMB), (const float*)(F.ws + WS_SSQH), (bf16*)(F.ws + WS_H)};
        pg8::gemm_phase<EpiGateUp, GroupedOrder, true, true>(F.lds + RING_OFF, (const bf16*)(F.ws + WS_H1B), (const bf16*)(F.ws + WS_WGU), DM, S, E);
        SEAM(5);
    }
    if (IN(6)) {
        REFRESH(); load_prefix(F);
        GroupedOrder S{F.MISC + 16, F.MISC + 64, F.MISC + 128, (const int*)(F.ws + WS_LIST), F.G, F.vcu, F.lds + GTAB_OFF};
        EpiDown E{(bf16*)(F.ws + WS_Y)};
        pg8::gemm_phase<EpiDown, GroupedOrder, true, false>(F.lds + RING_OFF, (const bf16*)(F.ws + WS_H), (const bf16*)(F.ws + WS_WD), DE, S, E);
        SEAM(6);
    }
    if (IN(7)) { REFRESH(); load_prefix(F); p6_final(F); }
#undef IN
#undef SEAM
}
#ifndef TEST_STAGE
#define TEST_STAGE 5
#endif
#if TEST_STAGE < 5
namespace dec {
__global__ void k_dec_qkv(const bf16* QF, const bf16* KF, const bf16* VF, float* qkv) {
    const size_t idx = (size_t)blockIdx.x * 256 + threadIdx.x; const int row = idx / 1536, col = idx % 1536, seg = col / 512, cc = col % 512, h = cc / 64, d = cc % 64, b = row / SEQ, s = row % SEQ, bh = b * 8 + h;
    float v;
    if (seg == 0) v = bf2f(QF[qk_index(bh, s, d)]) / C2; else if (seg == 1) v = bf2f(KF[qk_index(bh, s, d)]); else v = bf2f(VF[v_index(bh, s, d)]);
    qkv[idx] = v;
}
__global__ void k_dec_uv(const bf16* GUF, const bf16* GVF, float* uv) {
    const size_t idx = (size_t)blockIdx.x * 256 + threadIdx.x; const int row = idx / 1024, col = idx % 1024, seg = col / 512, cc = col % 512, h = cc / 64, d = cc % 64, b = row / SEQ, s = row % SEQ;
    uv[idx] = seg == 0 ? bf2f(GUF[gu_index(b, s, h, d)]) : bf2f(GVF[gv_index(b, s, h, d)]);
}
__global__ void k_dec_mixed(const bf16* M, const float* g1, const float* g2, float* out) {
    const size_t idx = (size_t)blockIdx.x * 256 + threadIdx.x; const int col = idx % 1024;
    out[idx] = bf2f(M[idx]) * (col < 512 ? g1[col] : g2[col - 512]);
}
__global__ void k_dec_bf16(const bf16* M, float* out) { const size_t idx = (size_t)blockIdx.x * 256 + threadIdx.x; out[idx] = bf2f(M[idx]); }
__global__ void k_dec_route(const unsigned* slot, const float* comb, int* sel, float* cw) {
    const int i = blockIdx.x * 256 + threadIdx.x; const unsigned s = slot[i]; const int e = s >> 16, p = s & 0xffff; sel[i] = e; cw[i] = comb[(size_t)e * CAP + p];
}
__global__ void k_sg_prep_pre(const float* uv, const float* g, float* vgn) {
    const int row = blockIdx.x * 4 + (threadIdx.x >> 6), lane = threadIdx.x & 63;
    float v[8], s = 0.f;
#pragma unroll
    for (int i = 0; i < 8; ++i) { v[i] = uv[(size_t)row * 1024 + 512 + lane + 64 * i]; s += v[i] * v[i]; }
    s = naive::wsum(s); const float r = rsqrtf(s / 512.f + EPS);
#pragma unroll
    for (int i = 0; i < 8; ++i) vgn[(size_t)row * 512 + lane + 64 * i] = v[i] * r * g[lane + 64 * i];
}
__global__ void k_sg_mix_pre(const float* uv, const float* vgn, const float* W, const float* bsp, float* sgo) {
    const int idx = blockIdx.x * 256 + threadIdx.x; const int row = idx / 512, c = idx % 512, h = c / 64;
    const int tl = row % CH, r0 = row - tl;
    float acc = 0.f;
    for (int s = 0; s <= tl; ++s) acc += W[(size_t)(h * CH + tl) * CH + s] * vgn[(size_t)(r0 + s) * 512 + c];
    acc += bsp[h * CH + tl];
    sgo[(size_t)row * 512 + c] = uv[(size_t)row * 1024 + c] * acc;
}
}
#endif

static void launch_mk(const Args& base, int lo, int hi, int grid, hipStream_t stream) {
    Args a = base; a.ph_lo = lo; a.ph_hi = hi;
    (void)hipMemsetAsync(base.ws + WS_CTL + CW_BAR * 4, 0, XCD_BAR_WORDS * 4, stream);
    hipLaunchKernelGGL(mk_fwd, dim3(grid), dim3(NWAVES * 64), LDS_BYTES, stream, a);
}

extern "C" void kernel_launch(void* const* d_in, const int* in_sizes, int n_in, void* d_out, int out_size, void* d_ws, size_t ws_size, hipStream_t stream) {
    static int grid = 0;
    if (grid == 0) {
        if (n_in != 18 || out_size != NTOK * DM || ws_size < WS_END) { fprintf(stderr, "kernel_launch: unexpected shapes (n_in %d out %d ws %zu)\n", n_in, out_size, ws_size); grid = -1; return; }
        int dev = 0, cus = 0, per_cu = 0;
        if (hipGetDevice(&dev) != hipSuccess || hipDeviceGetAttribute(&cus, hipDeviceAttributeMultiprocessorCount, dev) != hipSuccess) { grid = -1; return; }
        if (hipFuncSetAttribute((const void*)mk_fwd, hipFuncAttributeMaxDynamicSharedMemorySize, LDS_BYTES) != hipSuccess) { fprintf(stderr, "kernel_launch: hipFuncSetAttribute failed\n"); grid = -1; return; }
        if (hipOccupancyMaxActiveBlocksPerMultiprocessor(&per_cu, (const void*)mk_fwd, NWAVES * 64, LDS_BYTES) != hipSuccess || per_cu < 1) { fprintf(stderr, "kernel_launch: occupancy query says %d\n", per_cu); per_cu = 1; }
        (void)hipGetLastError();
        grid = cus;
    }
    if (grid < 0) return;
    Args a{};
    for (int i = 0; i < 18; ++i) a.in[i] = (const float*)d_in[i];
    a.out = (float*)d_out; a.ws = (unsigned char*)d_ws;
    (void)hipMemsetAsync((char*)d_ws + WS_CTL, 0, CTL_ZERO_BYTES, stream);
#if TEST_STAGE >= 5
#ifdef MK_SPLIT
    for (int p = 0; p <= N_PHASES; ++p) launch_mk(a, p, p + 1, grid, stream);
#else
    launch_mk(a, 0, N_PHASES + 1, grid, stream);
#endif
#else
    unsigned char* ws = (unsigned char*)d_ws; float* out = (float*)d_out;
    const float* x = a.in[0]; const float* sg_g = a.in[3]; const float* w_sp = a.in[4]; const float* b_sp = a.in[5]; const float* sbo_g = a.in[6]; const float* sgo_g = a.in[7];
    const float* w_out = a.in[8]; const float* ffn_g = a.in[9];
    float* R8 = (float*)(ws + 8 * MiB);
    float* R72 = (float*)(ws + 72 * MiB); float* R104 = (float*)(ws + 104 * MiB); float* R142 = (float*)(ws + 142 * MiB); float* R174 = (float*)(ws + 174 * MiB);
    int* sel = (int*)(ws + 206 * MiB); float* cw = (float*)(ws + 207 * MiB);
    float* h1 = (TEST_STAGE >= 3) ? R8 : R72;
#if TEST_STAGE == 1
    for (int p = 0; p <= 1; ++p) launch_mk(a, p, p + 1, grid, stream);
    dec::k_dec_qkv<<<NTOK * 1536 / 256, 256, 0, stream>>>((const bf16*)(ws + WS_QF), (const bf16*)(ws + WS_KF), (const bf16*)(ws + WS_VF), R8);
    naive::k_attn<<<NTOK * NH / 4, 256, 0, stream>>>(R8, R104);
    dec::k_dec_uv<<<NTOK * 1024 / 256, 256, 0, stream>>>((const bf16*)(ws + WS_GUF), (const bf16*)(ws + WS_GVF), R8);
    dec::k_sg_prep_pre<<<NTOK / 4, 256, 0, stream>>>(R8, sg_g, R72);
    dec::k_sg_mix_pre<<<NTOK * 512 / 256, 256, 0, stream>>>(R8, R72, w_sp, b_sp, R174);
    naive::k_rmsnorm<<<NTOK / 4, 256, 0, stream>>>(R104, 512, sbo_g, R8, 1024, NTOK, 512);
    naive::k_rmsnorm<<<NTOK / 4, 256, 0, stream>>>(R174, 512, sgo_g, R8 + 512, 1024, NTOK, 512);
    naive::k_gemm<<<dim3(1024 / 64, NTOK / 64), 256, 0, stream>>>(R8, 1024, w_out, 1024, h1, 1024, NTOK, 1024, 1024, x);
#elif TEST_STAGE == 2
    for (int p = 0; p <= 2; ++p) launch_mk(a, p, p + 1, grid, stream);
    dec::k_dec_mixed<<<NTOK * 1024 / 256, 256, 0, stream>>>((const bf16*)(ws + WS_MIXED), sbo_g, sgo_g, R8);
    naive::k_gemm<<<dim3(1024 / 64, NTOK / 64), 256, 0, stream>>>(R8, 1024, w_out, 1024, h1, 1024, NTOK, 1024, 1024, x);
#elif TEST_STAGE >= 3
    for (int p = 0; p <= TEST_STAGE; ++p) launch_mk(a, p, p + 1, grid, stream);
#endif
#if TEST_STAGE >= 3
    dec::k_dec_bf16<<<NTOK * 1024 / 256, 256, 0, stream>>>((const bf16*)(ws + WS_H1B), h1);
#endif
    naive::k_rmsnorm<<<NTOK / 4, 256, 0, stream>>>(h1, 1024, ffn_g, R142, 1024, NTOK, 1024);
#if TEST_STAGE == 4
    dec::k_dec_route<<<NTOK * 2 / 256, 256, 0, stream>>>((const unsigned*)(ws + WS_TOKSLOT), (const float*)(ws + WS_COMB), sel, cw);
#else
    naive::k_route<<<NTOK / 4, 256, 0, stream>>>(R142, a.in[10], a.in[11], a.in[12], a.in[13], sel, cw);
#endif
    naive::k_moe_final<<<NTOK, 512, 0, stream>>>(h1, R142, sel, cw, a.in[14], a.in[15], a.in[16], a.in[17], out);
#endif
}
```

```cpp
#define TEST_STAGE 5
#include <hip/hip_runtime.h>
#include <cstdio>
#include <cstdint>
#include <cmath>
namespace pg8 {
#define PG8_LAS __attribute__((address_space(3)))
typedef unsigned short bf16_t;
typedef short bf16x8 __attribute__((ext_vector_type(8)));
typedef float f32x4 __attribute__((ext_vector_type(4)));
typedef float f32x2 __attribute__((ext_vector_type(2)));
typedef unsigned u32x4 __attribute__((ext_vector_type(4)));
typedef unsigned u32x2 __attribute__((ext_vector_type(2)));
constexpr int BM = 256, BK = 64, HALF = 128, HTB = HALF * BK * 2  , STAGE_BYTES = 8 * HTB, NXCD = 8, WGM = 8;

__host__ __device__ __forceinline__ int lds_byte(int r, int c) { const int st = (r >> 4) * 2 + (c >> 5), rr = r & 15, cc = c & 31, ob = rr * 64 + cc * 2; return st * 1024 + (ob ^ (((ob >> 9) & 1) << 5)); }
__host__ __device__ __forceinline__ void stage_rc(int b, int& R, int& C) { const int st = b / 1024, sb = b % 1024, swz = sb ^ (((sb >> 9) & 1) << 5); R = (st >> 1) * 16 + swz / 64; C = (st & 1) * 32 + (swz % 64) / 2; }
__host__ __device__ __forceinline__ int perm32(int rho) { const int n = rho >> 4, i = rho & 15; return 8 * (i >> 2) + 4 * n + (i & 3); }

struct Unit { int arow, brow, pm, pn, e, nvalid, lbase; };

struct StaticOrder {
    int nM, nN, nwg, G, c;
    __host__ __device__ void init(int M, int N, int G_, int c_) { nM = M / BM; nN = N / BM; nwg = nM * nN; G = G_; c = c_; }
    __host__ __device__ bool next(int i, Unit& u) const {
        const long L = (long)i * G + c; if (L >= nwg) return false;
        int wgid = (int)L; { const int q = nwg / NXCD, r = nwg % NXCD, xcd = wgid % NXCD, off = wgid / NXCD; wgid = (xcd < r ? xcd * (q + 1) : r * (q + 1) + (xcd - r) * q) + off; }
        const int nig = WGM * nN, gid = wgid / nig, fm = gid * WGM, gsz = (nM - fm) < WGM ? (nM - fm) : WGM;
        u.pm = fm + ((wgid % nig) % gsz); u.pn = (wgid % nig) / gsz; u.arow = u.pm * BM; u.brow = u.pn * BM; u.e = 0; u.nvalid = BM; u.lbase = 0; return true;
    }
    PG8_LAS unsigned char* gtab;
};

__device__ __forceinline__ unsigned cvt_pk_bf16(float lo, float hi) { unsigned r; asm volatile("v_cvt_pk_bf16_f32 %0, %1, %2" : "=v"(r) : "v"(lo), "v"(hi)); return r; }

template <class Epi, class Sched, bool ALIGN_EPI, bool GATHER>
__device__ __forceinline__ void gemm_phase(PG8_LAS unsigned char* lds, const bf16_t* Aglob, const bf16_t* Btglob, const int K, const Sched& S, const Epi& E) {
    int tid_ = threadIdx.x; asm volatile("" : "+v"(tid_));
    const int tid = tid_, wid = __builtin_amdgcn_readfirstlane(tid >> 6), lane = tid & 63, wr = wid >> 2, wc = wid & 3, fr = lane & 15, fq = lane >> 4;
    const int nt = K / BK;
    int RA[2], CA[2]; unsigned voffB[2];
#pragma unroll
    for (int i = 0; i < 2; ++i) { int R, C; stage_rc(tid * 16 + i * 8192, R, C); const int Rb = Epi::PERM ? ((R & ~31) + perm32(R & 31)) : R;
        RA[i] = R; CA[i] = C; voffB[i] = (unsigned)(Rb * K + C) * 2u; }
    const size_t kstep = (size_t)(BK * 2);
    const size_t hstep = (size_t)HALF * K * 2;
    const unsigned ldsw = (unsigned)wid * 1024u;
    const int aoff = lds_byte(wr * 64 + fr, fq * 8), boff = lds_byte(wc * 32 + fr, fq * 8);
#define PG8_SA(b, h) (((b) * 2 + (h)) * HTB)
#define PG8_SB(b, h) ((4 + (b) * 2 + (h)) * HTB)
#define PG8_STAGE(bufoff, gbase, voff) do { _Pragma("unroll") for (int _i = 0; _i < 2; ++_i) \
        __builtin_amdgcn_global_load_lds((const unsigned*)((const char*)(gbase) + (voff)[_i]), (PG8_LAS unsigned*)(lds + (bufoff) + ldsw + _i * 8192), 16, 0, 0); } while (0)
#define PG8_LDA(dst, b, h) do { _Pragma("unroll") for (int m = 0; m < 4; ++m) _Pragma("unroll") for (int k = 0; k < 2; ++k) dst[m][k] = *(const PG8_LAS bf16x8*)(lds + PG8_SA(b, h) + aoff + m * 2048 + k * 1024); } while (0)
#define PG8_LDB(dst, b, h) do { _Pragma("unroll") for (int n = 0; n < 2; ++n) _Pragma("unroll") for (int k = 0; k < 2; ++k) dst[n][k] = *(const PG8_LAS bf16x8*)(lds + PG8_SB(b, h) + boff + n * 2048 + k * 1024); } while (0)
#define PG8_MMA(ai, bj, At, Bt) do { __builtin_amdgcn_s_setprio(1); _Pragma("unroll") for (int m = 0; m < 4; ++m) _Pragma("unroll") for (int n = 0; n < 2; ++n) _Pragma("unroll") for (int k = 0; k < 2; ++k) \
        acc[ai][bj][m][n] = __builtin_amdgcn_mfma_f32_16x16x32_bf16(Bt[n][k], At[m][k], acc[ai][bj][m][n], 0, 0, 0); __builtin_amdgcn_s_setprio(0); } while (0)
#define PG8_WAIT_V(n) asm volatile("s_waitcnt vmcnt(" #n ")" ::: "memory")
#define PG8_WAIT_L(n) asm volatile("s_waitcnt lgkmcnt(" #n ")" ::: "memory")
#define PG8_BAR __builtin_amdgcn_s_barrier()
#define PG8_SCHED __builtin_amdgcn_sched_barrier(0)
#define PG8_AOFFS(V, UI) do { if constexpr (GATHER) { const u32x4 _t = *(const PG8_LAS u32x4*)(S.gtab + ((UI) * 512 + tid) * 16); V[0][0] = _t.x; V[0][1] = _t.y; V[1][0] = _t.z; V[1][1] = _t.w; } \
        else { _Pragma("unroll") for (int _h = 0; _h < 2; ++_h) _Pragma("unroll") for (int _i = 0; _i < 2; ++_i) V[_h][_i] = (unsigned)((_h * HALF + RA[_i]) * K + CA[_i]) * 2u; } } while (0)
#define PG8_ABASE(U) (GATHER ? (const char*)Aglob : (const char*)Aglob + (size_t)(U).arow * K * 2)
    Unit cur, nxt; int ui = 0;
    if (!S.next(0, cur)) return;
    f32x4 acc[2][2][4][2];
#pragma unroll
    for (int a = 0; a < 2; ++a)
#pragma unroll
        for (int b = 0; b < 2; ++b)
#pragma unroll
            for (int m = 0; m < 4; ++m)
#pragma unroll
                for (int n = 0; n < 2; ++n) acc[a][b][m][n] = (f32x4){0.f, 0.f, 0.f, 0.f};
    bf16x8 At[4][2], B0[2][2], B1[2][2];
    unsigned vc[2][2];
    PG8_AOFFS(vc, 0);
    const char* cA = PG8_ABASE(cur); const char* cB = (const char*)Btglob + (size_t)cur.brow * K * 2;
    PG8_STAGE(PG8_SB(0, 0), cB, voffB); PG8_STAGE(PG8_SB(0, 1), cB + hstep, voffB); PG8_STAGE(PG8_SA(0, 0), cA, vc[0]); PG8_STAGE(PG8_SA(0, 1), cA, vc[1]);
    if (wr == 1) PG8_BAR;
    PG8_WAIT_V(2); PG8_BAR;
    PG8_STAGE(PG8_SB(1, 0), cB + kstep, voffB); PG8_STAGE(PG8_SA(1, 0), cA + kstep, vc[0]); PG8_STAGE(PG8_SB(1, 1), cB + hstep + kstep, voffB);
    PG8_WAIT_V(6); PG8_BAR;
    for (;;) {
        const bool has_next = S.next(ui + 1, nxt);
        const char* nA = has_next ? PG8_ABASE(nxt) : cA; const char* nB = has_next ? (const char*)Btglob + (size_t)nxt.brow * K * 2 : cB;
        for (int t = 0; t < nt; t += 2) {
            const bool last = (t == nt - 2);
            const char* a1 = cA + (size_t)(t + 1) * kstep;
            const char* a2 = last ? nA : cA + (size_t)(t + 2) * kstep; const char* b2 = last ? nB : cB + (size_t)(t + 2) * kstep;
            const char* a3 = a2 + kstep; const char* b3 = b2 + kstep;
            PG8_LDB(B0, 0, 0); PG8_LDB(B1, 0, 1); PG8_SCHED; PG8_LDA(At, 0, 0); PG8_STAGE(PG8_SA(1, 1), a1, vc[1]);
            if constexpr (GATHER) { if (last && has_next) PG8_AOFFS(vc, ui + 1); }
            PG8_WAIT_V(8); PG8_WAIT_L(0); PG8_BAR; PG8_MMA(0, 0, At, B0); PG8_MMA(0, 1, At, B1); PG8_BAR; PG8_SCHED;
            PG8_LDA(At, 0, 1); PG8_STAGE(PG8_SB(0, 0), b2, voffB); PG8_STAGE(PG8_SB(0, 1), b2 + hstep, voffB); PG8_STAGE(PG8_SA(0, 0), a2, vc[0]);
            PG8_WAIT_V(8); PG8_WAIT_L(0); PG8_BAR; PG8_MMA(1, 0, At, B0); PG8_MMA(1, 1, At, B1); PG8_BAR; PG8_SCHED;
            PG8_LDB(B0, 1, 0); PG8_LDB(B1, 1, 1); PG8_SCHED; PG8_LDA(At, 1, 0); PG8_STAGE(PG8_SA(0, 1), a2, vc[1]);
            PG8_WAIT_V(8); PG8_WAIT_L(0); PG8_BAR; PG8_MMA(0, 0, At, B0); PG8_MMA(0, 1, At, B1); PG8_BAR; PG8_SCHED;
            PG8_LDA(At, 1, 1); PG8_STAGE(PG8_SB(1, 0), b3, voffB); PG8_STAGE(PG8_SB(1, 1), b3 + hstep, voffB); PG8_STAGE(PG8_SA(1, 0), a3, vc[0]);
            PG8_WAIT_V(8); PG8_WAIT_L(0); PG8_BAR; PG8_MMA(1, 0, At, B0); PG8_MMA(1, 1, At, B1); PG8_BAR; PG8_SCHED;
        }
        if constexpr (ALIGN_EPI) { if (wr == 0) PG8_BAR; }
        E(acc, cur, wr, wc, fr, fq);
        if (!has_next) break;
#pragma unroll
        for (int a = 0; a < 2; ++a)
#pragma unroll
            for (int b = 0; b < 2; ++b)
#pragma unroll
                for (int m = 0; m < 4; ++m)
#pragma unroll
                    for (int n = 0; n < 2; ++n) acc[a][b][m][n] = (f32x4){0.f, 0.f, 0.f, 0.f};
        cur = nxt; cA = nA; cB = nB; ++ui;
        if constexpr (ALIGN_EPI) { if (wr == 1) PG8_BAR; }
    }
    PG8_WAIT_V(0);
    if constexpr (!ALIGN_EPI) { if (wr == 0) PG8_BAR; }
    PG8_BAR;
#undef PG8_SA
#undef PG8_SB
#undef PG8_STAGE
#undef PG8_LDA
#undef PG8_LDB
#undef PG8_MMA
#undef PG8_WAIT_V
#undef PG8_WAIT_L
#undef PG8_BAR
#undef PG8_SCHED
#undef PG8_AOFFS
#undef PG8_ABASE
}
}
constexpr int NTOK = 16384, DM = 1024, DIN = 2560, SEQ = 2048, NB = 8, NH = 8, HD = 64, CH = 128, NCH = 16, NE = 32, DE = 512, CAP = 16384;
constexpr float EPS = 1e-6f;
constexpr float C2 = 0.125f * 1.4426950408889634f;
constexpr int NWAVES = 8;
constexpr size_t MiB = 1u << 20;
constexpr size_t WS_CTL = 0, CTL_ZERO_BYTES = 64 * 1024;
constexpr size_t WS_SSQV = 1 * MiB, WS_SSQH = 1 * MiB + 64 * 1024, WS_TOKSLOT = 1 * MiB + 128 * 1024;
constexpr size_t WS_LIST = 2 * MiB, WS_COMB = 4 * MiB;
constexpr size_t WS_WR = 6 * MiB, WS_WSP = 6 * MiB + 512 * 1024;
constexpr size_t WS_WIN = 7 * MiB, WS_WOUT = 12 * MiB, WS_WGU = 14 * MiB, WS_WD = 78 * MiB;
constexpr size_t WS_H1B = 110 * MiB;
constexpr size_t WS_GUF = 142 * MiB, WS_GVF = 158 * MiB;
constexpr size_t WS_H = 142 * MiB;
constexpr size_t WS_HN = 174 * MiB, WS_QF = 206 * MiB, WS_KF = 222 * MiB, WS_VF = 238 * MiB;
constexpr size_t WS_MIXED = WS_HN, WS_Y = WS_HN, WS_END = 254 * MiB;
constexpr int CW_BAR = 4096;
constexpr int CW_CNT = 8192;
static_assert((CW_CNT + 64 * NE) * 4 <= (int)CTL_ZERO_BYTES, "ctl");
constexpr int RING_OFF = 0, RING_BYTES = 131072;
constexpr int MISC_OFF = RING_BYTES;
constexpr int GTAB_OFF = MISC_OFF + 4096;
constexpr int LDS_BYTES = 163840;

#define GAS __attribute__((address_space(1)))
#define LAS __attribute__((address_space(3)))
typedef unsigned short bf16;
typedef unsigned v4u __attribute__((ext_vector_type(4)));
typedef unsigned v2u __attribute__((ext_vector_type(2)));
typedef float f32x4 __attribute__((ext_vector_type(4)));
typedef float f32x16 __attribute__((ext_vector_type(16)));
typedef short bf16x8 __attribute__((ext_vector_type(8)));
typedef GAS unsigned gu32;
#define RLX_AGENT __ATOMIC_RELAXED, __HIP_MEMORY_SCOPE_AGENT
#define LDS_WAIT() asm volatile("s_waitcnt lgkmcnt(0)" ::: "memory")
#define VM_WAIT() asm volatile("s_waitcnt vmcnt(0)" ::: "memory")
__device__ __forceinline__ unsigned f2bf(float f) { unsigned u = __builtin_bit_cast(unsigned, f); return (u + 0x7fffu + ((u >> 16) & 1u)) >> 16; }
__device__ __forceinline__ unsigned pk2(float lo, float hi) { return f2bf(lo) | (f2bf(hi) << 16); }
__device__ __forceinline__ float bf2f(unsigned short b) { return __builtin_bit_cast(float, (unsigned)b << 16); }
__device__ __forceinline__ float bflo(unsigned w) { return __builtin_bit_cast(float, w << 16); }
__device__ __forceinline__ float bfhi(unsigned w) { return __builtin_bit_cast(float, w & 0xffff0000u); }
__device__ __forceinline__ int crow(int r, int hi) { return (r & 3) + 8 * (r >> 2) + 4 * hi; }
__device__ __forceinline__ int perm16(int i) { return (i & 3) + 4 * ((i >> 3) & 1) + 8 * ((i >> 2) & 1); }
__device__ __forceinline__ float gelu_tanh_f(float x) {
    const float y = x * (0.7978845608028654f + 0.0356774081363001f * x * x);
    return x * __builtin_amdgcn_rcpf(1.0f + __builtin_amdgcn_exp2f(-2.885390081777927f * y));
}
__device__ __forceinline__ float wave_sum(float v) {
#pragma unroll
    for (int o = 1; o < 64; o <<= 1) v += __shfl_xor(v, o);
    return v;
}

__host__ __device__ __forceinline__ size_t qk_index(int bh, int s, int d) { return ((((size_t)bh * 64 + (s >> 5)) * 4 + (d >> 4)) * 64 + ((d >> 3) & 1) * 32 + (s & 31)) * 8 + (d & 7); }
__host__ __device__ __forceinline__ size_t v_index(int bh, int s, int d) { const int i = s & 15, pos = (i & 3) + 4 * ((i >> 3) & 1) + 8 * ((i >> 2) & 1);
    return ((((((size_t)bh * 32 + (s >> 6)) * 2 + (d >> 5)) * 4 + ((s >> 4) & 3)) * 64 + (pos >> 3) * 32 + (d & 31)) * 8 + (pos & 7)); }
__host__ __device__ __forceinline__ size_t gu_index(int b, int s, int h, int d) { const int c = s >> 7, tb = (s >> 5) & 3, t = s & 31, db = d >> 5, dl = d & 31, hh = (dl >> 2) & 1, r = (dl & 3) + 4 * (dl >> 3);
    return (((((((size_t)b * 16 + c) * 8 + h) * 4 + tb) * 2 + db) * 64 + hh * 32 + t) * 16 + r); }
__host__ __device__ __forceinline__ size_t gv_index(int b, int s, int h, int d) { const int c = s >> 7, ks = (s & 127) >> 4;
    return (((((((size_t)b * 16 + c) * 8 + h) * 2 + (d >> 5)) * 8 + ks) * 64 + ((s >> 3) & 1) * 32 + (d & 31)) * 8 + (s & 7)); }

#define XB_TMO      128
#define XB_XCNT(j)  (256  + 64 * (j))
#define XB_XSUB(j)  (1280 + 64 * (j))
#define XB_XGEN(j)  (2304 + 64 * (j))
#define XB_TOP      3328
#define XB_TOPGEN   3392
#define XCD_BAR_WORDS 3456
#define XB_SPIN_CAP (1u << 18)
__device__ __forceinline__ unsigned xb_ld(unsigned* p)              { return __hip_atomic_load(p, __ATOMIC_RELAXED, __HIP_MEMORY_SCOPE_AGENT); }
__device__ __forceinline__ unsigned xb_add(unsigned* p, unsigned v) { return __hip_atomic_fetch_add(p, v, __ATOMIC_RELAXED, __HIP_MEMORY_SCOPE_AGENT); }
__device__ __forceinline__ unsigned xb_xcc_id() { return (unsigned)__builtin_amdgcn_s_getreg((3 << 11) | 20) & 0xFu; }
#define XB_SPIN(cond, bar) do { unsigned _sp = 0; while (cond) { __builtin_amdgcn_s_sleep(1); \
    if ((++_sp & 255u) == 0u) { if (xb_ld(&(bar)[XB_TMO])) break; if (_sp > XB_SPIN_CAP) { atomicAdd(&(bar)[XB_TMO], 1u); break; } } } } while (0)
struct XcdBarrier { unsigned* bar; unsigned x; volatile LAS unsigned* st; };
__device__ __forceinline__ XcdBarrier xcd_barrier_post(unsigned* bar, volatile LAS unsigned* st) {
    XcdBarrier b; b.bar = bar; b.x = xb_xcc_id(); b.st = st;
    if (threadIdx.x == 0) (void)xb_add(&bar[XB_XCNT(b.x)], 1u);
    return b;
}
__device__ __forceinline__ void xcd_barrier_complete(unsigned* bar, unsigned x, unsigned& nloc, unsigned& nx) {
    const unsigned G = gridDim.x * gridDim.y * gridDim.z;
    unsigned sum, cnt, mine, sp = 0u;
    for (;;) {
        sum = 0u; cnt = 0u; mine = 0u;
#pragma unroll
        for (unsigned j = 0; j < 16; ++j) { const unsigned c = xb_ld(&bar[XB_XCNT(j)]); sum += c; cnt += (c > 0u) ? 1u : 0u; mine = (j == x) ? c : mine; }
        if (sum == G) break;
        __builtin_amdgcn_s_sleep(1);
        if ((++sp & 255u) == 0u) { if (xb_ld(&bar[XB_TMO])) break; if (sp > XB_SPIN_CAP) { atomicAdd(&bar[XB_TMO], 1u); break; } }
    }
    nloc = mine > 0u ? mine : 1u; nx = cnt > 0u ? cnt : 1u;
}
__device__ __forceinline__ void xcd_barrier(const XcdBarrier& b) {
    asm volatile("s_waitcnt vmcnt(0)" ::: "memory");
    __syncthreads();
    if (threadIdx.x == 0) {
        unsigned* bar = b.bar;
        __builtin_amdgcn_s_waitcnt(0);
        unsigned nloc = b.st[0], nx = b.st[1];
        if (nloc == 0u) { xcd_barrier_complete(bar, b.x, nloc, nx); b.st[0] = nloc; b.st[1] = nx; }
        const unsigned old = xb_add(&bar[XB_XSUB(b.x)], 1u);
        const unsigned gen = old / nloc;
        if (old + 1u == (gen + 1u) * nloc) {
            __builtin_amdgcn_fence(__ATOMIC_RELEASE, "agent");
            asm volatile("s_waitcnt vmcnt(0)" ::: "memory");
            const unsigned og = xb_add(&bar[XB_TOP], 1u);
            const unsigned tg = og / nx;
            if (og + 1u == (tg + 1u) * nx) xb_add(&bar[XB_TOPGEN], 1u);
            else XB_SPIN(xb_ld(&bar[XB_TOPGEN]) == tg, bar);
            __builtin_amdgcn_fence(__ATOMIC_ACQUIRE, "agent");
            xb_add(&bar[XB_XGEN(b.x)], 1u);
            asm volatile("s_waitcnt vmcnt(0)" ::: "memory");
        } else {
            XB_SPIN(xb_ld(&bar[XB_XGEN(b.x)]) == gen, bar);
            __builtin_amdgcn_fence(__ATOMIC_ACQUIRE, "agent");
            asm volatile("s_waitcnt vmcnt(0)" ::: "memory");
        }
    }
    __syncthreads();
}

struct Frame {
    LAS unsigned char* lds;
    volatile LAS unsigned* MISC;
    gu32* ctl;
    int tid, lane, wave, vcu, G;
    const float *x, *attn_g, *w_in, *sg_g, *w_sp, *b_sp, *sbo_g, *sgo_g, *w_out, *ffn_g, *wrg, *brg, *wre, *bre, *wg, *wu, *wd, *fin_g;
    float* out;
    unsigned char* ws;
};
__device__ __forceinline__ void p0_transpose_item(const float* W, int K, int N, bf16* WT, int row_off, const float* gk, int item, int lane, LAS unsigned char* scr) {
    const int nblk = N / 64, kb = item / nblk, nb = item % nblk, k0 = 64 * kb, n0 = 64 * nb;
    const GAS float* src = (const GAS float*)W + (size_t)k0 * N + n0 + lane;
    float v[64];
#pragma unroll
    for (int j = 0; j < 64; ++j) v[j] = src[(size_t)j * N];
    if (gk) {
#pragma unroll
        for (int j = 0; j < 64; ++j) v[j] *= gk[k0 + j]; }
#pragma unroll
    for (int c = 0; c < 8; ++c) { v4u o; o.x = pk2(v[8 * c], v[8 * c + 1]); o.y = pk2(v[8 * c + 2], v[8 * c + 3]); o.z = pk2(v[8 * c + 4], v[8 * c + 5]); o.w = pk2(v[8 * c + 6], v[8 * c + 7]);
        *(LAS v4u*)(scr + lane * 144 + c * 16) = o; }
    LDS_WAIT(); asm volatile("" ::: "memory");
    const int rr = lane >> 3, cc = lane & 7;
    GAS unsigned char* dst = (GAS unsigned char*)(WT + (size_t)(row_off + n0 + rr) * K + k0 + 8 * cc);
#pragma unroll
    for (int i = 0; i < 8; ++i) { const v4u o = *(const LAS v4u*)(scr + (8 * i + rr) * 144 + cc * 16); *(GAS v4u*)(dst + (size_t)i * 8 * K * 2) = o; }
    LDS_WAIT(); asm volatile("" ::: "memory");
}
template <int NR> __device__ __forceinline__ void rms_rows_to_bf16(int lane, const float* xrow, bf16* orow, size_t rstride) {
    f32x4 v[NR][4]; float s[NR];
#pragma unroll
    for (int r = 0; r < NR; ++r) { const GAS f32x4* xr = (const GAS f32x4*)(xrow + r * rstride) + lane;
#pragma unroll
        for (int j = 0; j < 4; ++j) v[r][j] = xr[64 * j]; }
#pragma unroll
    for (int r = 0; r < NR; ++r) { s[r] = 0.f;
#pragma unroll
        for (int j = 0; j < 4; ++j) s[r] += (v[r][j].x * v[r][j].x + v[r][j].y * v[r][j].y) + (v[r][j].z * v[r][j].z + v[r][j].w * v[r][j].w);
        const float rstd = rsqrtf(wave_sum(s[r]) * (1.f / DM) + EPS);
        GAS unsigned long long* o8 = (GAS unsigned long long*)(orow + r * rstride) + lane;
#pragma unroll
        for (int j = 0; j < 4; ++j) o8[64 * j] = (unsigned long long)pk2(v[r][j].x * rstd, v[r][j].y * rstd) | ((unsigned long long)pk2(v[r][j].z * rstd, v[r][j].w * rstd) << 32); }
}
__device__ __forceinline__ void p0_prologue(Frame& F) {
    LAS unsigned char* scr = F.lds + RING_OFF + F.wave * 9216;
    const int gw = F.vcu * NWAVES + F.wave, NGW = F.G * NWAVES;
    const int gt = gw * 64 + F.lane, NGT = NGW * 64;
    bf16* WIN = (bf16*)(F.ws + WS_WIN); bf16* WOUT = (bf16*)(F.ws + WS_WOUT); bf16* WGU = (bf16*)(F.ws + WS_WGU); bf16* WD = (bf16*)(F.ws + WS_WD);
    { float* sv = (float*)(F.ws + WS_SSQV); float* sh = (float*)(F.ws + WS_SSQH);
      for (int i = gt; i < NTOK; i += NGT) { sv[i] = 0.f; sh[i] = 0.f; } }
    { bf16* WRH = (bf16*)(F.ws + WS_WR); bf16* WRL = WRH + 64 * 1024;
      for (int i = gt; i < 64 * 1024; i += NGT) { const int n = i >> 10, k = i & 1023; float w = 0.f;
          if (n < 4) w = F.wrg[k * 4 + n]; else if (n < 36) { const int g = (n - 4) >> 3, e = (n - 4) & 7; w = F.wre[((size_t)g * 1024 + k) * 8 + e]; }
          w *= F.ffn_g[k]; const unsigned hb = f2bf(w); const float hf = bf2f((unsigned short)hb); WRH[i] = (bf16)hb; WRL[i] = (bf16)f2bf(w - hf); } }
    { bf16* WSP = (bf16*)(F.ws + WS_WSP);
      for (int i = gt; i < NH * CH * CH; i += NGT) { const int s = i & 127, t = (i >> 7) & 127; WSP[i] = (s <= t) ? (bf16)f2bf(F.w_sp[i]) : (bf16)0; } }
    { bf16* HN = (bf16*)(F.ws + WS_HN);
      for (int m = gw; m < NTOK; m += 4 * NGW) rms_rows_to_bf16<4>(F.lane, F.x + (size_t)m * DM, HN + (size_t)m * DM, (size_t)NGW * DM); }
    constexpr int I_IN = (DM / 64) * (DIN / 64), I_OUT = (DM / 64) * (DM / 64);
    for (int it = gw; it < I_IN + I_OUT; it += NGW) {
        int r = it;
        if (r < I_IN) { p0_transpose_item(F.w_in, DM, DIN, WIN, 0, F.attn_g, r, F.lane, scr); continue; } r -= I_IN;
        const int kb = r / (DM / 64); const float* g = (kb < 8) ? F.sbo_g : (F.sgo_g - 512); p0_transpose_item(F.w_out, DM, DM, WOUT, 0, g, r, F.lane, scr);
    }
}
constexpr int MOE_A = 3, MOE_B = 9;
__device__ __forceinline__ void p1_moe_convert(Frame& F) {
    LAS unsigned char* scr = F.lds + RING_OFF + F.wave * 9216;
    bf16* WGU = (bf16*)(F.ws + WS_WGU); bf16* WD = (bf16*)(F.ws + WS_WD);
    constexpr int I_G = (DM / 64) * (DE / 64), I_D = (DE / 64) * (DM / 64), PER_E = 2 * I_G + I_D, NITEMS = NE * PER_E;
    const int bx = blockIdx.x, half = F.G / 2;
    int first, count, stride;
    if (F.G == 256) { if (bx >= half) { count = MOE_B; first = ((bx - half) * NWAVES + F.wave); stride = half * NWAVES; }
                      else { count = MOE_A; first = MOE_B * half * NWAVES + (bx * NWAVES + F.wave); stride = half * NWAVES; } }
    else { const int NGW = F.G * NWAVES; first = bx * NWAVES + F.wave; stride = NGW; count = (NITEMS - first + NGW - 1) / NGW; }
    for (int i = 0; i < count; ++i) {
        const int it = first + i * stride; if (it >= NITEMS) break;
        const int e = it / PER_E; int r = it - e * PER_E;
        if (r < 2 * I_G) { const int up = r / I_G; r -= up * I_G; const int nb = r % (DE / 64), n0 = 64 * nb, pn = n0 >> 7, j0 = n0 & 127;
            const float* W = (up ? F.wu : F.wg) + (size_t)e * DM * DE;
            p0_transpose_item(W, DM, DE, WGU, (4 * e + pn) * 256 + 128 * up + j0 - n0, F.ffn_g, r, F.lane, scr); continue; }
        r -= 2 * I_G;
        p0_transpose_item(F.wd + (size_t)e * DE * DM, DE, DM, WD, e * DM, nullptr, r, F.lane, scr);
    }
}
using pg8::Unit; using pg8::cvt_pk_bf16;
struct EpiInProj {
    static constexpr bool PERM = true;
    bf16 *QF, *KF, *VF, *GUF, *GVF; float* ssqv;
    __device__ __forceinline__ void operator()(const f32x4 (&acc)[2][2][4][2], const Unit& u, int wr, int wc, int fr, int fq) const {
        const int seg = u.pn >> 1, b = u.pm >> 3, sbase = (u.pm & 7) * 256 + wr * 64;
        const int db = wc & 1;
        if (seg <= 1) {
            bf16* dst = seg == 0 ? QF : KF; const float sc = seg == 0 ? C2 : 1.0f;
            const int dstep = 2 * db + (fq >> 1), hh = fq & 1;
#pragma unroll
            for (int bj = 0; bj < 2; ++bj) { const int bh = b * 8 + (u.pn & 1) * 4 + 2 * bj + (wc >> 1);
#pragma unroll
                for (int ai = 0; ai < 2; ++ai)
#pragma unroll
                    for (int m = 0; m < 4; ++m) { const int s = sbase + 128 * ai + 16 * m + fr;
                        const f32x4 v0 = acc[ai][bj][m][0] * sc, v1 = acc[ai][bj][m][1] * sc;
                        v4u w; w.x = cvt_pk_bf16(v0[0], v0[1]); w.y = cvt_pk_bf16(v0[2], v0[3]); w.z = cvt_pk_bf16(v1[0], v1[1]); w.w = cvt_pk_bf16(v1[2], v1[3]);
                        *(v4u*)(dst + ((((size_t)bh * 64 + (s >> 5)) * 4 + dstep) * 64 + hh * 32 + (s & 31)) * 8) = w; } }
        } else if (seg == 2) {
            const int pos = perm16(fr), hh = pos >> 3, pj = pos & 7;
#pragma unroll
            for (int bj = 0; bj < 2; ++bj) { const int bh = b * 8 + (u.pn & 1) * 4 + 2 * bj + (wc >> 1);
#pragma unroll
                for (int ai = 0; ai < 2; ++ai)
#pragma unroll
                    for (int m = 0; m < 4; ++m) { const int s = sbase + 128 * ai + 16 * m;
                        bf16* base = VF + ((((size_t)bh * 32 + (s >> 6)) * 2 + db) * 4 + ((s >> 4) & 3)) * 512 + (hh * 32 + 8 * fq) * 8 + pj;
#pragma unroll
                        for (int n = 0; n < 2; ++n)
#pragma unroll
                            for (int i = 0; i < 4; ++i) base[(4 * n + i) * 8] = (bf16)f2bf(acc[ai][bj][m][n][i]); } }
        } else if (seg == 3) {
#pragma unroll
            for (int bj = 0; bj < 2; ++bj) { const int h = (u.pn & 1) * 4 + 2 * bj + (wc >> 1);
#pragma unroll
                for (int ai = 0; ai < 2; ++ai)
#pragma unroll
                    for (int m = 0; m < 4; ++m) { const int s = sbase + 128 * ai + 16 * m + fr, c = s >> 7, tb = (s >> 5) & 3, t = s & 31;
                        bf16* base = GUF + ((((((size_t)b * 16 + c) * 8 + h) * 4 + tb) * 2 + db) * 64 + t) * 16 + 4 * fq;
#pragma unroll
                        for (int n = 0; n < 2; ++n) { const f32x4 v = acc[ai][bj][m][n];
                            v2u w; w.x = cvt_pk_bf16(gelu_tanh_f(v[0]), gelu_tanh_f(v[1])); w.y = cvt_pk_bf16(gelu_tanh_f(v[2]), gelu_tanh_f(v[3]));
                            *(v2u*)(base + n * 32 * 16) = w; } } }
        } else {
            const int hh = fr >> 3, pj = fr & 7;
#pragma unroll
            for (int ai = 0; ai < 2; ++ai)
#pragma unroll
                for (int m = 0; m < 4; ++m) { const int s = sbase + 128 * ai + 16 * m, c = s >> 7, ks = (s & 127) >> 4; float ss = 0.f;
#pragma unroll
                    for (int bj = 0; bj < 2; ++bj) { const int h = (u.pn & 1) * 4 + 2 * bj + (wc >> 1);
                        bf16* base = GVF + ((((((size_t)b * 16 + c) * 8 + h) * 2 + db) * 8 + ks) * 64 + hh * 32 + 8 * fq) * 8 + pj;
#pragma unroll
                        for (int n = 0; n < 2; ++n)
#pragma unroll
                            for (int i = 0; i < 4; ++i) { const float g = gelu_tanh_f(acc[ai][bj][m][n][i]); ss += g * g; base[(4 * n + i) * 8] = (bf16)f2bf(g); } }
                    ss += __shfl_xor(ss, 16); ss += __shfl_xor(ss, 32);
                    if (fq == 0) atomicAdd(ssqv + (size_t)b * SEQ + s + fr, ss); }
        }
    }
};
struct EpiOutProj {
    static constexpr bool PERM = true;
    const float* x; bf16* H1B; float* ssqh;
    __device__ __forceinline__ void operator()(const f32x4 (&acc)[2][2][4][2], const Unit& u, int wr, int wc, int fr, int fq) const {
#pragma unroll
        for (int ai = 0; ai < 2; ++ai)
#pragma unroll
            for (int m = 0; m < 4; ++m) { const int row = u.pm * 256 + 128 * ai + 64 * wr + 16 * m + fr; float ss = 0.f;
#pragma unroll
                for (int bj = 0; bj < 2; ++bj) { const size_t o = (size_t)row * DM + u.pn * 256 + 128 * bj + 32 * wc + 8 * fq;
                    const f32x4 v0 = acc[ai][bj][m][0] + *(const f32x4*)(x + o), v1 = acc[ai][bj][m][1] + *(const f32x4*)(x + o + 4);
                    ss += (v0[0] * v0[0] + v0[1] * v0[1]) + (v0[2] * v0[2] + v0[3] * v0[3]) + (v1[0] * v1[0] + v1[1] * v1[1]) + (v1[2] * v1[2] + v1[3] * v1[3]);
                    v4u w; w.x = cvt_pk_bf16(v0[0], v0[1]); w.y = cvt_pk_bf16(v0[2], v0[3]); w.z = cvt_pk_bf16(v1[0], v1[1]); w.w = cvt_pk_bf16(v1[2], v1[3]);
                    *(v4u*)(H1B + o) = w; }
                ss += __shfl_xor(ss, 16); ss += __shfl_xor(ss, 32);
                if (fq == 0) atomicAdd(ssqh + row, ss); }
    }
};
struct GroupedOrder {
    volatile LAS unsigned* tp; volatile LAS unsigned* rp; volatile LAS unsigned* cn; const int* list; int G, c; LAS unsigned char* gtab;
    __device__ __forceinline__ bool next(int i, Unit& u) const {
        const unsigned L = (unsigned)i * G + c, nunits = tp[32] * 4u; if (L >= nunits) return false;
        const unsigned tile = L >> 2; int e = 0;
        for (int j = 1; j < 32; ++j) e += (tp[j] <= tile) ? 1 : 0;
        const int rt = tile - tp[e];
        u.e = e; u.pn = L & 3; u.brow = 256 * (4 * e + u.pn); u.pm = rp[e] + 256 * rt; u.arow = u.pm;
        const int left = (int)cn[e] - 256 * rt; u.nvalid = left < 256 ? left : 256; u.lbase = e * CAP + 256 * rt; return true;
    }
    __device__ __forceinline__ int grow(const Unit& u, int j) const { const int jj = j < u.nvalid ? j : u.nvalid - 1; return list[u.lbase + jj]; }
    __device__ __forceinline__ void fill_gtab(int tid, int K) const {
        int RA[2], CA[2];
#pragma unroll
        for (int i = 0; i < 2; ++i) pg8::stage_rc(tid * 16 + i * 8192, RA[i], CA[i]);
        Unit u;
        for (int ui = 0; ui < 3 && next(ui, u); ++ui) { v4u t;
            t.x = (unsigned)((size_t)grow(u, RA[0]) * K + CA[0]) * 2u; t.y = (unsigned)((size_t)grow(u, RA[1]) * K + CA[1]) * 2u;
            t.z = (unsigned)((size_t)grow(u, 128 + RA[0]) * K + CA[0]) * 2u; t.w = (unsigned)((size_t)grow(u, 128 + RA[1]) * K + CA[1]) * 2u;
            *(LAS v4u*)(gtab + (ui * 512 + tid) * 16) = t; }
        __syncthreads();
    }
};
struct EpiGateUp {
    static constexpr bool PERM = true;
    const int* list; const float* comb; const float* ssqh; bf16* H;
    __device__ __forceinline__ void operator()(const f32x4 (&acc)[2][2][4][2], const Unit& u, int wr, int wc, int fr, int fq) const {
#pragma unroll
        for (int ai = 0; ai < 2; ++ai)
#pragma unroll
            for (int m = 0; m < 4; ++m) { const int r = 128 * ai + 64 * wr + 16 * m + fr;
                if (r < u.nvalid) { const int tok = list[u.lbase + r]; const float cw = comb[u.lbase + r]; const float rs = rsqrtf(ssqh[tok] * (1.f / DM) + EPS);
                    float hv[8];
#pragma unroll
                    for (int n = 0; n < 2; ++n)
#pragma unroll
                        for (int i = 0; i < 4; ++i) { const float g = acc[ai][0][m][n][i] * rs, up = acc[ai][1][m][n][i] * rs;
                            hv[4 * n + i] = g * __builtin_amdgcn_rcpf(1.0f + __builtin_amdgcn_exp2f(-1.4426950408889634f * g)) * up * cw; }
                    v4u w; w.x = cvt_pk_bf16(hv[0], hv[1]); w.y = cvt_pk_bf16(hv[2], hv[3]); w.z = cvt_pk_bf16(hv[4], hv[5]); w.w = cvt_pk_bf16(hv[6], hv[7]);
                    *(v4u*)(H + (size_t)(u.pm + r) * DE + 128 * u.pn + 32 * wc + 8 * fq) = w; } }
    }
};
struct EpiDown {
    static constexpr bool PERM = true;
    bf16* Y;
    __device__ __forceinline__ void operator()(const f32x4 (&acc)[2][2][4][2], const Unit& u, int wr, int wc, int fr, int fq) const {
#pragma unroll
        for (int ai = 0; ai < 2; ++ai)
#pragma unroll
            for (int m = 0; m < 4; ++m) { const int r = 128 * ai + 64 * wr + 16 * m + fr;
                if (r < u.nvalid) {
#pragma unroll
                    for (int bj = 0; bj < 2; ++bj) { const f32x4 v0 = acc[ai][bj][m][0], v1 = acc[ai][bj][m][1];
                        v4u w; w.x = cvt_pk_bf16(v0[0], v0[1]); w.y = cvt_pk_bf16(v0[2], v0[3]); w.z = cvt_pk_bf16(v1[0], v1[1]); w.w = cvt_pk_bf16(v1[2], v1[3]);
                        *(v4u*)(Y + (size_t)(u.pm + r) * DM + 256 * u.pn + 128 * bj + 32 * wc + 8 * fq) = w; } } }
    }
};
template <bool DIAG>
__device__ __forceinline__ void sb_block(const bf16x8 (&kf)[4], const bf16x8 (&vf)[4], const bf16x8 (&qf)[4], f32x16& o0, f32x16& o1, float& Pc, int q, int hh) {
    f32x16 st = {};
#pragma unroll
    for (int ds = 0; ds < 4; ++ds) st = __builtin_amdgcn_mfma_f32_32x32x16_bf16(kf[ds], qf[ds], st, 0, 0, 0);
    float bt[16], om[16];
#pragma unroll
    for (int r = 0; r < 16; ++r) {
        const float z = __builtin_fmaxf(st[r], -100.0f);
        const float e = __builtin_amdgcn_exp2f(-z);
        float b = __builtin_amdgcn_rcpf(1.0f + e), o = e * b;
        if (DIAG) { const bool valid = crow(r, hh) < q; b = valid ? b : 0.0f; o = valid ? o : 1.0f; }
        bt[r] = b; om[r] = o;
    }
    float gp[4], pg[4], pr[4];
#pragma unroll
    for (int g = 0; g < 4; ++g) { gp[g] = (om[4 * g] * om[4 * g + 1]) * (om[4 * g + 2] * om[4 * g + 3]); pg[g] = __shfl_xor(gp[g], 32); pr[g] = gp[g] * pg[g]; }
    const float T3 = Pc, T2 = T3 * pr[3], T1 = T2 * pr[2], T0 = T1 * pr[1];
    const float Tn[4] = {T0, T1, T2, T3};
    float a[16];
#pragma unroll
    for (int g = 0; g < 4; ++g) {
        float t = Tn[g] * (hh ? 1.0f : pg[g]);
        a[4 * g + 3] = bt[4 * g + 3] * t; t *= om[4 * g + 3];
        a[4 * g + 2] = bt[4 * g + 2] * t; t *= om[4 * g + 2];
        a[4 * g + 1] = bt[4 * g + 1] * t; t *= om[4 * g + 1];
        a[4 * g] = bt[4 * g] * t;
    }
    Pc = T0 * pr[0];
    v4u p0, p1;
    p0.x = cvt_pk_bf16(a[0], a[1]); p0.y = cvt_pk_bf16(a[2], a[3]); p0.z = cvt_pk_bf16(a[4], a[5]); p0.w = cvt_pk_bf16(a[6], a[7]);
    p1.x = cvt_pk_bf16(a[8], a[9]); p1.y = cvt_pk_bf16(a[10], a[11]); p1.z = cvt_pk_bf16(a[12], a[13]); p1.w = cvt_pk_bf16(a[14], a[15]);
    const bf16x8 pa0 = __builtin_bit_cast(bf16x8, p0), pa1 = __builtin_bit_cast(bf16x8, p1);
    o0 = __builtin_amdgcn_mfma_f32_32x32x16_bf16(vf[0], pa0, o0, 0, 0, 0); o0 = __builtin_amdgcn_mfma_f32_32x32x16_bf16(vf[1], pa1, o0, 0, 0, 0);
    o1 = __builtin_amdgcn_mfma_f32_32x32x16_bf16(vf[2], pa0, o1, 0, 0, 0); o1 = __builtin_amdgcn_mfma_f32_32x32x16_bf16(vf[3], pa1, o1, 0, 0, 0);
}
#define SB_LOAD(KD, VD, kb_) do { const int _kb = (kb_); \
    _Pragma("unroll") for (int _d = 0; _d < 4; ++_d) KD[_d] = KFv[(((size_t)bh * 64 + _kb) * 4 + _d) * 64 + lane]; \
    _Pragma("unroll") for (int _d = 0; _d < 2; ++_d) _Pragma("unroll") for (int _s = 0; _s < 2; ++_s) VD[_d * 2 + _s] = VFv[((((size_t)bh * 32 + (_kb >> 1)) * 2 + _d) * 4 + 2 * (_kb & 1) + _s) * 64 + lane]; } while (0)

__device__ __forceinline__ void attn_task(Frame& F, int b, int qb, LAS float* red) {
    const int lane = F.lane, h = F.wave, bh = b * 8 + h, q = lane & 31, hh = lane >> 5;
    const GAS bf16x8* QFv = (const GAS bf16x8*)(F.ws + WS_QF); const GAS bf16x8* KFv = (const GAS bf16x8*)(F.ws + WS_KF); const GAS bf16x8* VFv = (const GAS bf16x8*)(F.ws + WS_VF);
    bf16x8 qf[4], kf[4], vf[4], kn[4], vn[4];
#pragma unroll
    for (int ds = 0; ds < 4; ++ds) qf[ds] = QFv[(((size_t)bh * 64 + qb) * 4 + ds) * 64 + lane];
    SB_LOAD(kf, vf, qb);
    f32x16 o0 = {}, o1 = {}; float Pc = 1.0f;
    { const int kp = qb > 0 ? qb - 1 : 0; SB_LOAD(kn, vn, kp); }
    sb_block<true>(kf, vf, qf, o0, o1, Pc, q, hh);
    for (int kb = qb - 1; kb >= 0; --kb) {
        if (__all(Pc < 1.1754944e-38f)) break;
#pragma unroll
        for (int i = 0; i < 4; ++i) { kf[i] = kn[i]; vf[i] = vn[i]; }
        { const int kp = kb > 0 ? kb - 1 : 0; SB_LOAD(kn, vn, kp); }
        sb_block<false>(kf, vf, qf, o0, o1, Pc, q, hh);
    }
    float ss = 0.f;
#pragma unroll
    for (int r = 0; r < 16; ++r) ss += o0[r] * o0[r] + o1[r] * o1[r];
    ss += __shfl_xor(ss, 32);
    if (hh == 0) red[h * 32 + q] = ss;
    __syncthreads();
    float tot = 0.f;
#pragma unroll
    for (int w = 0; w < 8; ++w) tot += red[w * 32 + q];
    const float rstd = rsqrtf(tot * (1.f / 512.f) + EPS);
    bf16* mrow = (bf16*)(F.ws + WS_MIXED) + ((size_t)b * SEQ + qb * 32 + q) * DM + h * 64 + 4 * hh;
#pragma unroll
    for (int g = 0; g < 4; ++g) {
        v2u w0, w1;
        w0.x = cvt_pk_bf16(o0[4 * g] * rstd, o0[4 * g + 1] * rstd); w0.y = cvt_pk_bf16(o0[4 * g + 2] * rstd, o0[4 * g + 3] * rstd);
        w1.x = cvt_pk_bf16(o1[4 * g] * rstd, o1[4 * g + 1] * rstd); w1.y = cvt_pk_bf16(o1[4 * g + 2] * rstd, o1[4 * g + 3] * rstd);
        *(GAS v2u*)(mrow + 8 * g) = w0; *(GAS v2u*)(mrow + 32 + 8 * g) = w1;
    }
    __syncthreads();
}

template <int p> __device__ __forceinline__ void sg_task(Frame& F, int b, int c, LAS float* rsv, LAS float* red) {
    const int lane = F.lane, h = F.wave, t = lane & 31, hh = lane >> 5;
    const float* ssqv = (const float*)(F.ws + WS_SSQV);
    if (F.tid < 128) rsv[F.tid] = rsqrtf(__hip_atomic_load(ssqv + (size_t)b * SEQ + c * 128 + F.tid, RLX_AGENT) * (1.f / 512.f) + EPS);
    __syncthreads();
    constexpr int tbA = p ? 2 : 3, tbB = p ? 1 : 0, KS = 2 * (tbA + 1), KSB = 2 * (tbB + 1);
    const GAS bf16x8* GVv = (const GAS bf16x8*)(F.ws + WS_GVF) + (((size_t)b * 16 + c) * 8 + h) * 2 * 8 * 64;
    const GAS bf16x8* WSv = (const GAS bf16x8*)(F.ws + WS_WSP);
    const float g0 = F.sg_g[h * 64 + t], g1 = F.sg_g[h * 64 + 32 + t];
    f32x16 aA0 = {}, aA1 = {}, aB0 = {}, aB1 = {};
#pragma unroll
    for (int ks = 0; ks < KS; ++ks) {
        const bf16x8 r0 = GVv[(0 * 8 + ks) * 64 + lane], r1 = GVv[(1 * 8 + ks) * 64 + lane];
        const bf16x8 wA = WSv[((size_t)(h * 128 + 32 * tbA + t) * 128 + 16 * ks + 8 * hh) >> 3];
        const f32x4 s0 = *(const LAS f32x4*)(rsv + 16 * ks + 8 * hh), s1 = *(const LAS f32x4*)(rsv + 16 * ks + 8 * hh + 4);
        const v4u u0 = __builtin_bit_cast(v4u, r0), u1 = __builtin_bit_cast(v4u, r1);
        v4u x0, x1;
        x0.x = cvt_pk_bf16(bflo(u0.x) * s0[0] * g0, bfhi(u0.x) * s0[1] * g0); x0.y = cvt_pk_bf16(bflo(u0.y) * s0[2] * g0, bfhi(u0.y) * s0[3] * g0);
        x0.z = cvt_pk_bf16(bflo(u0.z) * s1[0] * g0, bfhi(u0.z) * s1[1] * g0); x0.w = cvt_pk_bf16(bflo(u0.w) * s1[2] * g0, bfhi(u0.w) * s1[3] * g0);
        x1.x = cvt_pk_bf16(bflo(u1.x) * s0[0] * g1, bfhi(u1.x) * s0[1] * g1); x1.y = cvt_pk_bf16(bflo(u1.y) * s0[2] * g1, bfhi(u1.y) * s0[3] * g1);
        x1.z = cvt_pk_bf16(bflo(u1.z) * s1[0] * g1, bfhi(u1.z) * s1[1] * g1); x1.w = cvt_pk_bf16(bflo(u1.w) * s1[2] * g1, bfhi(u1.w) * s1[3] * g1);
        const bf16x8 a0 = __builtin_bit_cast(bf16x8, x0), a1 = __builtin_bit_cast(bf16x8, x1);
        aA0 = __builtin_amdgcn_mfma_f32_32x32x16_bf16(a0, wA, aA0, 0, 0, 0); aA1 = __builtin_amdgcn_mfma_f32_32x32x16_bf16(a1, wA, aA1, 0, 0, 0);
        if (ks < KSB) { const bf16x8 wB = WSv[((size_t)(h * 128 + 32 * tbB + t) * 128 + 16 * ks + 8 * hh) >> 3];
            aB0 = __builtin_amdgcn_mfma_f32_32x32x16_bf16(a0, wB, aB0, 0, 0, 0); aB1 = __builtin_amdgcn_mfma_f32_32x32x16_bf16(a1, wB, aB1, 0, 0, 0); }
    }
    const GAS bf16x8* GUv = (const GAS bf16x8*)(F.ws + WS_GUF) + ((((size_t)b * 16 + c) * 8 + h) * 4) * 2 * 64 * 2;
    const float biasA = F.b_sp[h * 128 + 32 * tbA + t], biasB = F.b_sp[h * 128 + 32 * tbB + t];
    float ssA = 0.f, ssB = 0.f;
#define SG_GATE(ACC, TB, DB, BIAS, SS) do { const bf16x8 _g0 = GUv[(((TB) * 2 + (DB)) * 64 + lane) * 2], _g1 = GUv[(((TB) * 2 + (DB)) * 64 + lane) * 2 + 1]; \
        _Pragma("unroll") for (int _r = 0; _r < 8; ++_r) { ACC[_r] = bf2f((unsigned short)_g0[_r]) * (ACC[_r] + BIAS); ACC[_r + 8] = bf2f((unsigned short)_g1[_r]) * (ACC[_r + 8] + BIAS); \
            SS += ACC[_r] * ACC[_r] + ACC[_r + 8] * ACC[_r + 8]; } } while (0)
    SG_GATE(aA0, tbA, 0, biasA, ssA); SG_GATE(aA1, tbA, 1, biasA, ssA); SG_GATE(aB0, tbB, 0, biasB, ssB); SG_GATE(aB1, tbB, 1, biasB, ssB);
#undef SG_GATE
    ssA += __shfl_xor(ssA, 32); ssB += __shfl_xor(ssB, 32);
    if (hh == 0) { red[h * 32 + t] = ssA; red[256 + h * 32 + t] = ssB; }
    __syncthreads();
    float totA = 0.f, totB = 0.f;
#pragma unroll
    for (int w = 0; w < 8; ++w) { totA += red[w * 32 + t]; totB += red[256 + w * 32 + t]; }
    const float rsA = rsqrtf(totA * (1.f / 512.f) + EPS), rsB = rsqrtf(totB * (1.f / 512.f) + EPS);
    bf16* mA = (bf16*)(F.ws + WS_MIXED) + ((size_t)b * SEQ + c * 128 + 32 * tbA + t) * DM + 512 + h * 64 + 4 * hh;
    bf16* mB = (bf16*)(F.ws + WS_MIXED) + ((size_t)b * SEQ + c * 128 + 32 * tbB + t) * DM + 512 + h * 64 + 4 * hh;
#pragma unroll
    for (int g = 0; g < 4; ++g) {
        v2u w;
        w.x = cvt_pk_bf16(aA0[4 * g] * rsA, aA0[4 * g + 1] * rsA); w.y = cvt_pk_bf16(aA0[4 * g + 2] * rsA, aA0[4 * g + 3] * rsA); *(GAS v2u*)(mA + 8 * g) = w;
        w.x = cvt_pk_bf16(aA1[4 * g] * rsA, aA1[4 * g + 1] * rsA); w.y = cvt_pk_bf16(aA1[4 * g + 2] * rsA, aA1[4 * g + 3] * rsA); *(GAS v2u*)(mA + 32 + 8 * g) = w;
        w.x = cvt_pk_bf16(aB0[4 * g] * rsB, aB0[4 * g + 1] * rsB); w.y = cvt_pk_bf16(aB0[4 * g + 2] * rsB, aB0[4 * g + 3] * rsB); *(GAS v2u*)(mB + 8 * g) = w;
        w.x = cvt_pk_bf16(aB1[4 * g] * rsB, aB1[4 * g + 1] * rsB); w.y = cvt_pk_bf16(aB1[4 * g + 2] * rsB, aB1[4 * g + 3] * rsB); *(GAS v2u*)(mB + 32 + 8 * g) = w;
    }
    __syncthreads();
}

__device__ __forceinline__ void p2_phase(Frame& F) {
    LAS float* red = (LAS float*)(F.lds + RING_OFF); LAS float* rsv = red + 512;
    for (int i = F.vcu; i < 256; i += F.G) { if (i & 1) sg_task<1>(F, i >> 5, (i >> 1) & 15, rsv, red); else sg_task<0>(F, i >> 5, (i >> 1) & 15, rsv, red); }
    for (int i = F.vcu; i < 512; i += F.G) { const int j = 511 - i; attn_task(F, j >> 6, j & 63, red); }
}
__device__ __forceinline__ void route_task(Frame& F, int task) {
    const int lane = F.lane, w = F.wave, tg = w & 1, kq = w >> 1, r32 = lane & 31, hh = lane >> 5;
    LAS float* part = (LAS float*)(F.lds + RING_OFF);
    LAS unsigned* lc = (LAS unsigned*)(F.lds + RING_OFF + 4 * 64 * 65 * 4);
    const int tok0 = task * 64;
    const GAS bf16x8* Av = (const GAS bf16x8*)(F.ws + WS_H1B);
    const GAS bf16x8* Wh = (const GAS bf16x8*)(F.ws + WS_WR); const GAS bf16x8* Wl = Wh + 64 * 128;
    if (F.tid < 64) lc[F.tid] = 0u;
    f32x16 c0 = {}, c1 = {};
#pragma unroll 8
    for (int ks = 0; ks < 16; ++ks) {
        const int kv = kq * 32 + ks * 2 + hh;
        const bf16x8 a = Av[(size_t)(tok0 + tg * 32 + r32) * 128 + kv];
        const bf16x8 b0h = Wh[(size_t)r32 * 128 + kv], b0l = Wl[(size_t)r32 * 128 + kv], b1h = Wh[(size_t)(32 + r32) * 128 + kv], b1l = Wl[(size_t)(32 + r32) * 128 + kv];
        c0 = __builtin_amdgcn_mfma_f32_32x32x16_bf16(a, b0h, c0, 0, 0, 0); c0 = __builtin_amdgcn_mfma_f32_32x32x16_bf16(a, b0l, c0, 0, 0, 0);
        c1 = __builtin_amdgcn_mfma_f32_32x32x16_bf16(a, b1h, c1, 0, 0, 0); c1 = __builtin_amdgcn_mfma_f32_32x32x16_bf16(a, b1l, c1, 0, 0, 0);
    }
#pragma unroll
    for (int r = 0; r < 16; ++r) { const int tk = tg * 32 + crow(r, hh); part[(kq * 64 + tk) * 65 + r32] = c0[r]; part[(kq * 64 + tk) * 65 + 32 + r32] = c1[r]; }
    __syncthreads();
    int e1 = 0, e2 = 0, rk1 = 0, rk2 = 0; float cw1 = 0.f, cw2 = 0.f;
    const int tok = tok0 + F.tid;
    if (F.tid < 64) {
        const float rs = rsqrtf(__hip_atomic_load((float*)(F.ws + WS_SSQH) + tok, RLX_AGENT) * (1.f / DM) + EPS);
#define LG(n) ((part[(0 * 64 + F.tid) * 65 + (n)] + part[(1 * 64 + F.tid) * 65 + (n)]) + (part[(2 * 64 + F.tid) * 65 + (n)] + part[(3 * 64 + F.tid) * 65 + (n)]))
        float gl[4];
#pragma unroll
        for (int g = 0; g < 4; ++g) gl[g] = LG(g) * rs + F.brg[g];
        int gi = 0; float gm = gl[0];
#pragma unroll
        for (int g = 1; g < 4; ++g) if (gl[g] > gm) { gm = gl[g]; gi = g; }
        float den = 0.f;
#pragma unroll
        for (int g = 0; g < 4; ++g) den += __expf(gl[g] - gm);
        const float gw = 1.f / den;
        int i1 = 0, i2 = 0; float m1 = -INFINITY, m2 = -INFINITY;
        for (int e = 0; e < 8; ++e) { const float v = LG(4 + gi * 8 + e) * rs + F.bre[gi * 8 + e];
            if (v > m1) { m2 = m1; i2 = i1; m1 = v; i1 = e; } else if (v > m2) { m2 = v; i2 = e; } }
#undef LG
        const float p2 = __expf(m2 - m1), w1 = 1.f / (1.f + p2);
        e1 = gi * 8 + i1; e2 = gi * 8 + i2; cw1 = gw * w1; cw2 = gw * (p2 * w1);
        rk1 = (int)atomicAdd((unsigned*)&lc[e1], 1u); rk2 = (int)atomicAdd((unsigned*)&lc[e2], 1u);
    }
    __syncthreads();
    if (F.tid < 32) { const unsigned n = lc[F.tid]; lc[32 + F.tid] = n ? __hip_atomic_fetch_add((unsigned*)(F.ctl + CW_CNT + 64 * F.tid), n, RLX_AGENT) : 0u; }
    __syncthreads();
    if (F.tid < 64) {
        int* list = (int*)(F.ws + WS_LIST); float* comb = (float*)(F.ws + WS_COMB); unsigned* slot = (unsigned*)(F.ws + WS_TOKSLOT);
        const int p1 = (int)lc[32 + e1] + rk1, p2_ = (int)lc[32 + e2] + rk2;
        list[e1 * CAP + p1] = tok; comb[e1 * CAP + p1] = cw1; slot[tok * 2] = ((unsigned)e1 << 16) | (unsigned)p1;
        list[e2 * CAP + p2_] = tok; comb[e2 * CAP + p2_] = cw2; slot[tok * 2 + 1] = ((unsigned)e2 << 16) | (unsigned)p2_;
    }
    __syncthreads();
}
__device__ __forceinline__ void load_prefix(Frame& F) {
    if (F.tid == 0) { unsigned tp = 0, rp = 0;
        for (int e = 0; e < 32; ++e) { const unsigned n = __hip_atomic_load((unsigned*)(F.ctl + CW_CNT + 64 * e), RLX_AGENT);
            F.MISC[16 + e] = tp; F.MISC[64 + e] = rp; F.MISC[128 + e] = n; tp += (n + 255u) >> 8; rp += n; }
        F.MISC[16 + 32] = tp; F.MISC[64 + 32] = rp; }
    __syncthreads();
}
__device__ __forceinline__ void p6_final(Frame& F) {
    const int gw = F.vcu * NWAVES + F.wave, NGW = F.G * NWAVES, lane = F.lane;
    const bf16* H1B = (const bf16*)(F.ws + WS_H1B); const bf16* Y = (const bf16*)(F.ws + WS_Y); const unsigned* slot = (const unsigned*)(F.ws + WS_TOKSLOT);
    for (int g4 = gw; g4 < NTOK / 4; g4 += NGW) {
        const int tok0 = g4 * 4;
        const unsigned sv = slot[tok0 * 2 + (lane & 7)];
        v4u a[4][2], y1[4][2], y2[4][2];
#pragma unroll
        for (int t = 0; t < 4; ++t) {
            const unsigned s1 = __builtin_amdgcn_readlane(sv, 2 * t), s2 = __builtin_amdgcn_readlane(sv, 2 * t + 1);
            const size_t r1 = F.MISC[64 + (s1 >> 16)] + (s1 & 0xffffu), r2 = F.MISC[64 + (s2 >> 16)] + (s2 & 0xffffu);
#pragma unroll
            for (int j = 0; j < 2; ++j) { const int col = j * 512 + lane * 8;
                a[t][j] = *(const GAS v4u*)(H1B + (size_t)(tok0 + t) * DM + col); y1[t][j] = *(const GAS v4u*)(Y + r1 * DM + col); y2[t][j] = *(const GAS v4u*)(Y + r2 * DM + col); } }
#pragma unroll
        for (int t = 0; t < 4; ++t) {
            float v[16]; float ss = 0.f;
#pragma unroll
            for (int j = 0; j < 2; ++j)
#pragma unroll
                for (int i = 0; i < 4; ++i) { v[8 * j + 2 * i] = bflo(a[t][j][i]) + bflo(y1[t][j][i]) + bflo(y2[t][j][i]); v[8 * j + 2 * i + 1] = bfhi(a[t][j][i]) + bfhi(y1[t][j][i]) + bfhi(y2[t][j][i]); }
#pragma unroll
            for (int i = 0; i < 16; ++i) ss += v[i] * v[i];
            const float rstd = rsqrtf(wave_sum(ss) * (1.f / DM) + EPS);
#pragma unroll
            for (int j = 0; j < 2; ++j) { const int col = j * 512 + lane * 8; const f32x4 g0 = *(const f32x4*)(F.fin_g + col), g1 = *(const f32x4*)(F.fin_g + col + 4);
                f32x4 o0, o1;
#pragma unroll
                for (int i = 0; i < 4; ++i) { o0[i] = v[8 * j + i] * rstd * g0[i]; o1[i] = v[8 * j + 4 + i] * rstd * g1[i]; }
                *(GAS f32x4*)(F.out + (size_t)(tok0 + t) * DM + col) = o0; *(GAS f32x4*)(F.out + (size_t)(tok0 + t) * DM + col + 4) = o1; }
        }
    }
}
struct Args { const float* in[18]; float* out; unsigned char* ws; int ph_lo, ph_hi; };
constexpr int N_PHASES = 7;
__global__ void __launch_bounds__(NWAVES * 64, 2) mk_fwd(Args args) {
    extern __shared__ __attribute__((aligned(16))) unsigned char lds[];
    Frame F;
    F.lds = (LAS unsigned char*)lds;
    F.MISC = (volatile LAS unsigned*)(F.lds + MISC_OFF);
#define REFRESH() do { int t_ = threadIdx.x; asm volatile("" : "+v"(t_)); F.tid = t_; F.lane = t_ & 63; F.wave = __builtin_amdgcn_readfirstlane(t_ >> 6); } while (0)
    REFRESH();
    F.G = gridDim.x; { const int bx = blockIdx.x; F.vcu = (F.G % 8 == 0) ? (bx % 8) * (F.G / 8) + bx / 8 : bx; }
    F.ws = args.ws; F.ctl = (gu32*)(args.ws + WS_CTL); F.out = args.out;
    F.x = args.in[0]; F.attn_g = args.in[1]; F.w_in = args.in[2]; F.sg_g = args.in[3]; F.w_sp = args.in[4]; F.b_sp = args.in[5]; F.sbo_g = args.in[6]; F.sgo_g = args.in[7];
    F.w_out = args.in[8]; F.ffn_g = args.in[9]; F.wrg = args.in[10]; F.brg = args.in[11]; F.wre = args.in[12]; F.bre = args.in[13]; F.wg = args.in[14]; F.wu = args.in[15];
    F.wd = args.in[16]; F.fin_g = args.in[17];
    for (int u = F.tid; u < 4096 / 4; u += NWAVES * 64) ((LAS unsigned*)(F.lds + MISC_OFF))[u] = 0u;
    __syncthreads();
    const int lo = args.ph_lo, hi = args.ph_hi;
    XcdBarrier bar; bar.bar = (unsigned*)(F.ctl + CW_BAR); bar.x = 0; bar.st = nullptr;
    if (hi - lo > 1) bar = xcd_barrier_post((unsigned*)(F.ctl + CW_BAR), F.MISC + 0);
#ifndef PH_MASK
#define PH_MASK 0xff
#endif
#define IN(k) (((PH_MASK >> (k)) & 1) && lo <= (k) && (k) < hi)
#define SEAM(k) do { if (IN(k) && IN((k) + 1)) xcd_barrier(bar); } while (0)
    if (IN(0)) { REFRESH(); p0_prologue(F); SEAM(0); }
    if (IN(1)) {
        pg8::StaticOrder S; S.init(NTOK, DIN, F.G, (int)blockIdx.x);
        EpiInProj E{(bf16*)(F.ws + WS_QF), (bf16*)(F.ws + WS_KF), (bf16*)(F.ws + WS_VF), (bf16*)(F.ws + WS_GUF), (bf16*)(F.ws + WS_GVF), (float*)(F.ws + WS_SSQV)};
        pg8::gemm_phase<EpiInProj, pg8::StaticOrder, true, false>(F.lds + RING_OFF, (const bf16*)(F.ws + WS_HN), (const bf16*)(F.ws + WS_WIN), DM, S, E);
        REFRESH(); p1_moe_convert(F);
#ifdef REPC
        for (int r_ = 0; r_ < REPC; ++r_) { xcd_barrier(bar); p1_moe_convert(F); }
#endif
        SEAM(1);
    }
    if (IN(2)) { REFRESH(); p2_phase(F);
#ifdef REP2
        for (int r_ = 0; r_ < REP2; ++r_) { xcd_barrier(bar); p2_phase(F); }
#endif
        SEAM(2); }
    if (IN(3)) {
        pg8::StaticOrder S; S.init(NTOK, DM, F.G, (int)blockIdx.x);
        EpiOutProj E{F.x, (bf16*)(F.ws + WS_H1B), (float*)(F.ws + WS_SSQH)};
        pg8::gemm_phase<EpiOutProj, pg8::StaticOrder, false, false>(F.lds + RING_OFF, (const bf16*)(F.ws + WS_MIXED), (const bf16*)(F.ws + WS_WOUT), DM, S, E);
        SEAM(3);
    }
    if (IN(4)) { REFRESH(); for (int t = F.vcu; t < NTOK / 64; t += F.G) route_task(F, t); SEAM(4); }
    if (IN(5)) {
        REFRESH(); load_prefix(F);
        GroupedOrder S{F.MISC + 16, F.MISC + 64, F.MISC + 128, (const int*)(F.ws + WS_LIST), F.G, F.vcu, F.lds + GTAB_OFF};
        S.fill_gtab(F.tid, DM);
        EpiGateUp E{(const int*)(F.ws + WS_LIST), (const float*)(F.ws + WS_COMB), (const float*)(F.ws + WS_SSQH), (bf16*)(F.ws + WS_H)};
        pg8::gemm_phase<EpiGateUp, GroupedOrder, true, true>(F.lds + RING_OFF, (const bf16*)(F.ws + WS_H1B), (const bf16*)(F.ws + WS_WGU), DM, S, E);
        SEAM(5);
    }
    if (IN(6)) {
        REFRESH(); load_prefix(F);
        GroupedOrder S{F.MISC + 16, F.MISC + 64, F.MISC + 128, (const int*)(F.ws + WS_LIST), F.G, F.vcu, F.lds + GTAB_OFF};
        EpiDown E{(bf16*)(F.ws + WS_Y)};
        pg8::gemm_phase<EpiDown, GroupedOrder, true, false>(F.lds + RING_OFF, (const bf16*)(F.ws + WS_H), (const bf16*)(F.ws + WS_WD), DE, S, E);
        SEAM(6);
    }
    if (IN(7)) { REFRESH(); load_prefix(F); p6_final(F);
#ifdef REP7
        for (int r_ = 0; r_ < REP7; ++r_) { xcd_barrier(bar); p6_final(F); }
#endif
    }
#undef IN
#undef SEAM
}
#ifndef TEST_STAGE
#define TEST_STAGE 5
#endif
#if TEST_STAGE < 5
namespace dec {
__global__ void k_dec_qkv(const bf16* QF, const bf16* KF, const bf16* VF, float* qkv) {
    const size_t idx = (size_t)blockIdx.x * 256 + threadIdx.x; const int row = idx / 1536, col = idx % 1536, seg = col / 512, cc = col % 512, h = cc / 64, d = cc % 64, b = row / SEQ, s = row % SEQ, bh = b * 8 + h;
    float v;
    if (seg == 0) v = bf2f(QF[qk_index(bh, s, d)]) / C2; else if (seg == 1) v = bf2f(KF[qk_index(bh, s, d)]); else v = bf2f(VF[v_index(bh, s, d)]);
    qkv[idx] = v;
}
__global__ void k_dec_uv(const bf16* GUF, const bf16* GVF, float* uv) {
    const size_t idx = (size_t)blockIdx.x * 256 + threadIdx.x; const int row = idx / 1024, col = idx % 1024, seg = col / 512, cc = col % 512, h = cc / 64, d = cc % 64, b = row / SEQ, s = row % SEQ;
    uv[idx] = seg == 0 ? bf2f(GUF[gu_index(b, s, h, d)]) : bf2f(GVF[gv_index(b, s, h, d)]);
}
__global__ void k_dec_mixed(const bf16* M, const float* g1, const float* g2, float* out) {
    const size_t idx = (size_t)blockIdx.x * 256 + threadIdx.x; const int col = idx % 1024;
    out[idx] = bf2f(M[idx]) * (col < 512 ? g1[col] : g2[col - 512]);
}
__global__ void k_dec_bf16(const bf16* M, float* out) { const size_t idx = (size_t)blockIdx.x * 256 + threadIdx.x; out[idx] = bf2f(M[idx]); }
__global__ void k_dec_route(const unsigned* slot, const float* comb, int* sel, float* cw) {
    const int i = blockIdx.x * 256 + threadIdx.x; const unsigned s = slot[i]; const int e = s >> 16, p = s & 0xffff; sel[i] = e; cw[i] = comb[(size_t)e * CAP + p];
}
__global__ void k_sg_prep_pre(const float* uv, const float* g, float* vgn) {
    const int row = blockIdx.x * 4 + (threadIdx.x >> 6), lane = threadIdx.x & 63;
    float v[8], s = 0.f;
#pragma unroll
    for (int i = 0; i < 8; ++i) { v[i] = uv[(size_t)row * 1024 + 512 + lane + 64 * i]; s += v[i] * v[i]; }
    s = naive::wsum(s); const float r = rsqrtf(s / 512.f + EPS);
#pragma unroll
    for (int i = 0; i < 8; ++i) vgn[(size_t)row * 512 + lane + 64 * i] = v[i] * r * g[lane + 64 * i];
}
__global__ void k_sg_mix_pre(const float* uv, const float* vgn, const float* W, const float* bsp, float* sgo) {
    const int idx = blockIdx.x * 256 + threadIdx.x; const int row = idx / 512, c = idx % 512, h = c / 64;
    const int tl = row % CH, r0 = row - tl;
    float acc = 0.f;
    for (int s = 0; s <= tl; ++s) acc += W[(size_t)(h * CH + tl) * CH + s] * vgn[(size_t)(r0 + s) * 512 + c];
    acc += bsp[h * CH + tl];
    sgo[(size_t)row * 512 + c] = uv[(size_t)row * 1024 + c] * acc;
}
}
#endif

static void launch_mk(const Args& base, int lo, int hi, int grid, hipStream_t stream) {
    Args a = base; a.ph_lo = lo; a.ph_hi = hi;
    (void)hipMemsetAsync(base.ws + WS_CTL + CW_BAR * 4, 0, XCD_BAR_WORDS * 4, stream);
    hipLaunchKernelGGL(mk_fwd, dim3(grid), dim3(NWAVES * 64), LDS_BYTES, stream, a);
}

extern "C" void kernel_launch(void* const* d_in, const int* in_sizes, int n_in, void* d_out, int out_size, void* d_ws, size_t ws_size, hipStream_t stream) {
    static int grid = 0;
    if (grid == 0) {
        if (n_in != 18 || out_size != NTOK * DM || ws_size < WS_END) { fprintf(stderr, "kernel_launch: unexpected shapes (n_in %d out %d ws %zu)\n", n_in, out_size, ws_size); grid = -1; return; }
        int dev = 0, cus = 0, per_cu = 0;
        if (hipGetDevice(&dev) != hipSuccess || hipDeviceGetAttribute(&cus, hipDeviceAttributeMultiprocessorCount, dev) != hipSuccess) { grid = -1; return; }
        if (hipFuncSetAttribute((const void*)mk_fwd, hipFuncAttributeMaxDynamicSharedMemorySize, LDS_BYTES) != hipSuccess) { fprintf(stderr, "kernel_launch: hipFuncSetAttribute failed\n"); grid = -1; return; }
        if (hipOccupancyMaxActiveBlocksPerMultiprocessor(&per_cu, (const void*)mk_fwd, NWAVES * 64, LDS_BYTES) != hipSuccess || per_cu < 1) { fprintf(stderr, "kernel_launch: occupancy query says %d\n", per_cu); per_cu = 1; }
        (void)hipGetLastError();
        grid = cus;
    }
    if (grid < 0) return;
    Args a{};
    for (int i = 0; i < 18; ++i) a.in[i] = (const float*)d_in[i];
    a.out = (float*)d_out; a.ws = (unsigned char*)d_ws;
    (void)hipMemsetAsync((char*)d_ws + WS_CTL, 0, CTL_ZERO_BYTES, stream);
#if TEST_STAGE >= 5
#ifdef MK_SPLIT
    for (int p = 0; p <= N_PHASES; ++p) launch_mk(a, p, p + 1, grid, stream);
#else
    launch_mk(a, 0, N_PHASES + 1, grid, stream);
#ifdef PROBE_PREFIX
    (void)hipMemsetAsync((char*)d_ws + WS_CTL, 0, CTL_ZERO_BYTES, stream);
    launch_mk(a, 0, PROBE_PREFIX + 1, grid, stream);
#endif
#endif
#else
    unsigned char* ws = (unsigned char*)d_ws; float* out = (float*)d_out;
    const float* x = a.in[0]; const float* sg_g = a.in[3]; const float* w_sp = a.in[4]; const float* b_sp = a.in[5]; const float* sbo_g = a.in[6]; const float* sgo_g = a.in[7];
    const float* w_out = a.in[8]; const float* ffn_g = a.in[9];
    float* R8 = (float*)(ws + 8 * MiB);
    float* R72 = (float*)(ws + 72 * MiB); float* R104 = (float*)(ws + 104 * MiB); float* R142 = (float*)(ws + 142 * MiB); float* R174 = (float*)(ws + 174 * MiB);
    int* sel = (int*)(ws + 206 * MiB); float* cw = (float*)(ws + 207 * MiB);
    float* h1 = (TEST_STAGE >= 3) ? R8 : R72;
#if TEST_STAGE == 1
    for (int p = 0; p <= 1; ++p) launch_mk(a, p, p + 1, grid, stream);
    dec::k_dec_qkv<<<NTOK * 1536 / 256, 256, 0, stream>>>((const bf16*)(ws + WS_QF), (const bf16*)(ws + WS_KF), (const bf16*)(ws + WS_VF), R8);
    naive::k_attn<<<NTOK * NH / 4, 256, 0, stream>>>(R8, R104);
    dec::k_dec_uv<<<NTOK * 1024 / 256, 256, 0, stream>>>((const bf16*)(ws + WS_GUF), (const bf16*)(ws + WS_GVF), R8);
    dec::k_sg_prep_pre<<<NTOK / 4, 256, 0, stream>>>(R8, sg_g, R72);
    dec::k_sg_mix_pre<<<NTOK * 512 / 256, 256, 0, stream>>>(R8, R72, w_sp, b_sp, R174);
    naive::k_rmsnorm<<<NTOK / 4, 256, 0, stream>>>(R104, 512, sbo_g, R8, 1024, NTOK, 512);
    naive::k_rmsnorm<<<NTOK / 4, 256, 0, stream>>>(R174, 512, sgo_g, R8 + 512, 1024, NTOK, 512);
    naive::k_gemm<<<dim3(1024 / 64, NTOK / 64), 256, 0, stream>>>(R8, 1024, w_out, 1024, h1, 1024, NTOK, 1024, 1024, x);
#elif TEST_STAGE == 2
    for (int p = 0; p <= 2; ++p) launch_mk(a, p, p + 1, grid, stream);
    dec::k_dec_mixed<<<NTOK * 1024 / 256, 256, 0, stream>>>((const bf16*)(ws + WS_MIXED), sbo_g, sgo_g, R8);
    naive::k_gemm<<<dim3(1024 / 64, NTOK / 64), 256, 0, stream>>>(R8, 1024, w_out, 1024, h1, 1024, NTOK, 1024, 1024, x);
#elif TEST_STAGE >= 3
    for (int p = 0; p <= TEST_STAGE; ++p) launch_mk(a, p, p + 1, grid, stream);
#endif
#if TEST_STAGE >= 3
    dec::k_dec_bf16<<<NTOK * 1024 / 256, 256, 0, stream>>>((const bf16*)(ws + WS_H1B), h1);
#endif
    naive::k_rmsnorm<<<NTOK / 4, 256, 0, stream>>>(h1, 1024, ffn_g, R142, 1024, NTOK, 1024);
#if TEST_STAGE == 4
    dec::k_dec_route<<<NTOK * 2 / 256, 256, 0, stream>>>((const unsigned*)(ws + WS_TOKSLOT), (const float*)(ws + WS_COMB), sel, cw);
#else
    naive::k_route<<<NTOK / 4, 256, 0, stream>>>(R142, a.in[10], a.in[11], a.in[12], a.in[13], sel, cw);
#endif
    naive::k_moe_final<<<NTOK, 512, 0, stream>>>(h1, R142, sel, cw, a.in[14], a.in[15], a.in[16], a.in[17], out);
#endif
}
```
